# Optimizing an MI355X kernel written in HIP

```python
import math
import jax, jax.numpy as jnp
from jax import lax
import numpy as np

D_MODEL = 1024
BATCH = 2
SEQ = 8192
DEPTH = 1

CHUNK = 64
Q_BLOCK = 128
EPS = 1e-6

DA_HEADS = 4
DA_HEAD_DIM = 64
DA_V_DIM = 2 * DA_HEAD_DIM
DA_QK = DA_HEADS * 2 * DA_HEAD_DIM
DA_WIDTH = DA_HEADS * DA_V_DIM

GDN_HEADS = 4
GDN_K_DIM = 128
GDN_V_DIM = 128
GDN_QK = GDN_HEADS * GDN_K_DIM
GDN_WIDTH = GDN_HEADS * GDN_V_DIM
CONV_WIDTH = 4

N_BRANCHES = 2
D_IN = 2 * DA_QK + 2 * DA_WIDTH + 2 * GDN_QK + 2 * GDN_WIDTH + 2 * GDN_HEADS + N_BRANCHES * D_MODEL

kernel_name = "hybrid_diffattn_gdn_gated_merge"


def rms_norm(x, w):
    xf = x.astype(jnp.float32)
    y = xf * lax.rsqrt(jnp.mean(xf * xf, axis=-1, keepdims=True) + EPS)
    return (y * w.astype(jnp.float32)).astype(x.dtype)


def l2_norm(x):
    return x * lax.rsqrt(jnp.sum(x * x, axis=-1, keepdims=True) + EPS)


def lambda_init_for(layer):
    return 0.8 - 0.6 * math.exp(-0.3 * layer)


def diff_attention(q, k, v, q_gain, k_gain, lam_qk, out_gain, lambda_init):
    B, S, _ = q.shape
    nb = S // Q_BLOCK
    q = rms_norm(q.reshape(B, S, DA_HEADS, 2, DA_HEAD_DIM), q_gain)
    k = rms_norm(k.reshape(B, S, DA_HEADS, 2, DA_HEAD_DIM), k_gain)
    lam_f = lam_qk.astype(jnp.float32)
    lam = (jnp.exp(jnp.sum(lam_f[0] * lam_f[1])) - jnp.exp(jnp.sum(lam_f[2] * lam_f[3]))
           + lambda_init)
    qb = q.reshape(B, nb, Q_BLOCK, DA_HEADS, 2, DA_HEAD_DIM).transpose(1, 0, 3, 4, 2, 5)
    kf = k.transpose(0, 2, 3, 1, 4).astype(jnp.float32)
    vf = v.reshape(B, S, DA_HEADS, DA_V_DIM).transpose(0, 2, 1, 3).astype(jnp.float32)
    key_chunk = jnp.arange(S) // CHUNK
    scale = DA_HEAD_DIM ** -0.5

    def block(args):
        q_blk, blk = args
        q_chunk = (blk * Q_BLOCK + jnp.arange(Q_BLOCK)) // CHUNK
        mask = key_chunk[None, :] <= q_chunk[:, None]
        s = jnp.einsum('bhmqd,bhmkd->bhmqk', q_blk.astype(jnp.float32), kf) * scale
        p = jax.nn.softmax(jnp.where(mask, s, -jnp.inf), axis=-1)
        p = p[:, :, 0] - lam * p[:, :, 1]
        return jnp.einsum('bhqk,bhkd->bhqd', p, vf)

    o = lax.map(block, (qb, jnp.arange(nb)))
    o = o.transpose(1, 0, 3, 2, 4).reshape(B, S, DA_HEADS, DA_V_DIM)
    o = rms_norm(o, out_gain) * (1.0 - lambda_init)
    return o.reshape(B, S, DA_WIDTH).astype(v.dtype)


def short_conv(x, w):
    C = x.shape[-1]
    y = lax.conv_general_dilated(x, w[:, None, :].astype(x.dtype), window_strides=(1,),
                                 padding=[(CONV_WIDTH - 1, 0)],
                                 dimension_numbers=('NWC', 'WIO', 'NWC'),
                                 feature_group_count=C)
    return jax.nn.silu(y)


def gated_delta_rule(q, k, v, g, beta):
    B, H, S, dk = q.shape
    dv = v.shape[-1]
    n = S // CHUNK
    q = q * dk ** -0.5

    def rs(t):
        return t.reshape(B, H, n, CHUNK, *t.shape[3:])

    q, k, v, g, beta = rs(q), rs(k), rs(v), rs(g), rs(beta)
    g = jnp.cumsum(g, axis=-1)
    tri_incl = jnp.tril(jnp.ones((CHUNK, CHUNK), dtype=bool))
    tri_strict = jnp.tril(jnp.ones((CHUNK, CHUNK), dtype=bool), -1)
    gamma = jnp.exp(jnp.where(tri_incl, g[..., :, None] - g[..., None, :], -jnp.inf))
    k_beta = k * beta[..., None]
    v_beta = v * beta[..., None]
    a_strict = jnp.where(tri_strict, jnp.einsum('bhnid,bhnjd->bhnij', k_beta, k) * gamma, 0.0)
    eye = jnp.eye(CHUNK, dtype=q.dtype)
    rhs = jnp.concatenate([v_beta, k_beta * jnp.exp(g)[..., None]], axis=-1)
    sol = lax.linalg.triangular_solve(a_strict + eye, rhs, left_side=True, lower=True)
    u = sol[..., :dv]
    w = sol[..., dv:]
    a_intra = jnp.where(tri_incl, jnp.einsum('bhnid,bhnjd->bhnij', q, k) * gamma, 0.0)
    q_dec = q * jnp.exp(g)[..., None]
    k_tail = k * jnp.exp(g[..., -1:] - g)[..., None]
    g_last = jnp.exp(g[..., -1])

    def nf(t):
        return jnp.moveaxis(t, 2, 0)

    def step(state, inp):
        u_c, w_c, qd_c, kt_c, a_c, gl_c = inp
        v_new = u_c - jnp.einsum('bhcd,bhde->bhce', w_c, state)
        o_c = (jnp.einsum('bhcd,bhde->bhce', qd_c, state)
               + jnp.einsum('bhij,bhje->bhie', a_c, v_new))
        state = state * gl_c[..., None, None] + jnp.einsum('bhcd,bhce->bhde', kt_c, v_new)
        return state, o_c

    s0 = jnp.zeros((B, H, dk, dv), dtype=q.dtype)
    _, o = lax.scan(step, s0, (nf(u), nf(w), nf(q_dec), nf(k_tail), nf(a_intra), nf(g_last)))
    return o.transpose(1, 2, 0, 3, 4).reshape(B, H, S, dv)


def gated_deltanet(q, k, v, a, b, conv_w, a_log, dt_bias):
    B, S, _ = q.shape
    qkv = short_conv(jnp.concatenate([q, k, v], axis=-1), conv_w).astype(jnp.float32)
    q, k, v = jnp.split(qkv, [GDN_QK, 2 * GDN_QK], axis=-1)
    q = l2_norm(q.reshape(B, S, GDN_HEADS, GDN_K_DIM)).transpose(0, 2, 1, 3)
    k = l2_norm(k.reshape(B, S, GDN_HEADS, GDN_K_DIM)).transpose(0, 2, 1, 3)
    v = v.reshape(B, S, GDN_HEADS, GDN_V_DIM).transpose(0, 2, 1, 3)
    af = a.astype(jnp.float32)
    g = -jnp.exp(a_log.astype(jnp.float32)) * jax.nn.softplus(af + dt_bias.astype(jnp.float32))
    beta = jax.nn.sigmoid(b.astype(jnp.float32))
    o = gated_delta_rule(q, k, v, g.transpose(0, 2, 1), beta.transpose(0, 2, 1))
    return o.transpose(0, 2, 1, 3)


def setup_inputs(seed: int = 0) -> dict:
    key = jax.random.key(seed)
    ks = jax.random.split(key, 16)
    f32 = jnp.float32
    x = jax.random.normal(ks[0], (BATCH, SEQ, D_MODEL), f32)
    norm_w = 1.0 + 0.02 * jax.random.normal(ks[1], (DEPTH, D_MODEL), f32)
    w_in = jax.random.normal(ks[2], (DEPTH, D_MODEL, D_IN), f32) * D_MODEL ** -0.5
    da_q_gain = 1.0 + 0.02 * jax.random.normal(ks[3], (DEPTH, DA_HEAD_DIM), f32)
    da_k_gain = 1.0 + 0.02 * jax.random.normal(ks[4], (DEPTH, DA_HEAD_DIM), f32)
    da_lambda = 0.1 * jax.random.normal(ks[5], (DEPTH, 4, DA_HEAD_DIM), f32)
    da_out_gain = 1.0 + 0.02 * jax.random.normal(ks[6], (DEPTH, DA_V_DIM), f32)
    gdn_conv_w = jax.random.normal(ks[7], (DEPTH, CONV_WIDTH, 2 * GDN_QK + GDN_WIDTH), f32) * CONV_WIDTH ** -0.5
    gdn_a_log = jnp.log(jax.random.uniform(ks[8], (DEPTH, GDN_HEADS), f32, 1.0, 16.0))
    dt = jnp.exp(jax.random.uniform(ks[9], (DEPTH, GDN_HEADS), f32, math.log(1e-3), math.log(1e-1)))
    gdn_dt_bias = dt + jnp.log(-jnp.expm1(-dt))
    gdn_norm_w = 1.0 + 0.02 * jax.random.normal(ks[10], (DEPTH, GDN_V_DIM), f32)
    w_up_da = jax.random.normal(ks[11], (DEPTH, DA_WIDTH, D_MODEL), f32) * DA_WIDTH ** -0.5
    w_up_gdn = jax.random.normal(ks[12], (DEPTH, GDN_WIDTH, D_MODEL), f32) * GDN_WIDTH ** -0.5
    w_out = jax.random.normal(ks[13], (DEPTH, D_MODEL, D_MODEL), f32) * D_MODEL ** -0.5
    return {"x": x, "norm_w": norm_w, "w_in": w_in, "da_q_gain": da_q_gain,
            "da_k_gain": da_k_gain, "da_lambda": da_lambda, "da_out_gain": da_out_gain,
            "gdn_conv_w": gdn_conv_w, "gdn_a_log": gdn_a_log, "gdn_dt_bias": gdn_dt_bias,
            "gdn_norm_w": gdn_norm_w, "w_up_da": w_up_da, "w_up_gdn": w_up_gdn, "w_out": w_out}


def reference(x, norm_w, w_in, da_q_gain, da_k_gain, da_lambda, da_out_gain,
              gdn_conv_w, gdn_a_log, gdn_dt_bias, gdn_norm_w, w_up_da, w_up_gdn, w_out):
    B, S, _ = x.shape
    sizes = [DA_QK, DA_QK, DA_WIDTH, DA_WIDTH, GDN_QK, GDN_QK, GDN_WIDTH, GDN_WIDTH,
             GDN_HEADS, GDN_HEADS, N_BRANCHES * D_MODEL]
    split_points = [int(s) for s in np.cumsum(sizes)[:-1]]
    for l in range(DEPTH):
        lambda_init = lambda_init_for(l)
        h = rms_norm(x, norm_w[l])
        proj = jnp.einsum('bsd,de->bse', h, w_in[l])
        qa, ka, va, za, qb, kb, vb, zb, ab, bb, gate = jnp.split(proj, split_points, axis=-1)
        ya = diff_attention(qa, ka, va, da_q_gain[l], da_k_gain[l], da_lambda[l],
                            da_out_gain[l], lambda_init) * jax.nn.silu(za)
        ob = gated_deltanet(qb, kb, vb, ab, bb, gdn_conv_w[l], gdn_a_log[l], gdn_dt_bias[l])
        ob = rms_norm(ob, gdn_norm_w[l]).astype(x.dtype)
        yb = ob.reshape(B, S, GDN_WIDTH) * jax.nn.silu(zb)
        gates = jax.nn.sigmoid(gate.reshape(B, S, N_BRANCHES, D_MODEL))
        merged = (gates[:, :, 0] * jnp.einsum('bsw,wd->bsd', ya, w_up_da[l])
                  + gates[:, :, 1] * jnp.einsum('bsw,wd->bsd', yb, w_up_gdn[l]))
        x = x + jnp.einsum('bsd,de->bse', merged, w_out[l]).astype(x.dtype)
    return x
```

```cpp
#include <hip/hip_runtime.h>
#include <cstdio>
#include <cstdint>
#include <cmath>
namespace pg8 {
#define PG8_LAS __attribute__((address_space(3)))
typedef unsigned short bf16_t;
typedef short bf16x8 __attribute__((ext_vector_type(8)));
typedef float f32x4 __attribute__((ext_vector_type(4)));
typedef unsigned u32x4 __attribute__((ext_vector_type(4)));
constexpr int BM = 256, BK = 64, HALF = 128, HTB = HALF * BK * 2  , STAGE_BYTES = 8 * HTB, NXCD = 8, WGM = 8;

__host__ __device__ __forceinline__ int lds_byte(int r, int c) { const int st = (r >> 4) * 2 + (c >> 5), rr = r & 15, cc = c & 31, ob = rr * 64 + cc * 2; return st * 1024 + (ob ^ (((ob >> 9) & 1) << 5)); }
__host__ __device__ __forceinline__ void stage_rc(int b, int& R, int& C) { const int st = b / 1024, sb = b % 1024, swz = sb ^ (((sb >> 9) & 1) << 5); R = (st >> 1) * 16 + swz / 64; C = (st & 1) * 32 + (swz % 64) / 2; }
__host__ __device__ __forceinline__ int perm32(int rho) { const int n = rho >> 4, i = rho & 15; return 8 * (i >> 2) + 4 * n + (i & 3); }

struct Unit { int pm, pn; };
struct Gemm { const bf16_t* A; const bf16_t* Bt; int M, N, K; };

struct StaticOrder {
    int nM, nN, nwg, G, c;
    __host__ __device__ void init(int M, int N, int G_, int c_) { nM = M / BM; nN = N / BM; nwg = nM * nN; G = G_; c = c_; aoff_bytes = 0; aoff_pn = 1 << 30; }
    __host__ __device__ bool next(int i, Unit& u) const {
        const long L = (long)i * G + c; if (L >= nwg) return false;
        int wgid = (int)L; { const int q = nwg / NXCD, r = nwg % NXCD, xcd = wgid % NXCD, off = wgid / NXCD; wgid = (xcd < r ? xcd * (q + 1) : r * (q + 1) + (xcd - r) * q) + off; }
        const int nig = WGM * nN, gid = wgid / nig, fm = gid * WGM, gsz = (nM - fm) < WGM ? (nM - fm) : WGM;
        u.pm = fm + ((wgid % nig) % gsz); u.pn = (wgid % nig) / gsz; return true;
    }
    size_t aoff_bytes; int aoff_pn;
    __device__ __forceinline__ size_t a_off(const Unit& u) const { return u.pn >= aoff_pn ? aoff_bytes : (size_t)0; }
    __device__ __forceinline__ void a_ready(const Unit&) const {}
    __device__ __forceinline__ void done(const Unit&) const {}
};

__device__ __forceinline__ unsigned cvt_pk_bf16(float lo, float hi) { unsigned r; asm volatile("v_cvt_pk_bf16_f32 %0, %1, %2" : "=v"(r) : "v"(lo), "v"(hi)); return r; }
typedef float f32x2 __attribute__((ext_vector_type(2)));
__device__ __forceinline__ float fast_sigmoid(float x) { return __builtin_amdgcn_rcpf(1.0f + __builtin_amdgcn_exp2f(-1.4426950408889634f * x)); }
struct EpiProj {
    static constexpr bool PERM = true, AFTER_DRAIN = false;
    bf16_t *qkva, *za, *qkvb, *zb, *gate; const float *qg, *kg; float c2;
    __device__ __forceinline__ void operator()(const f32x4 (&acc)[2][2][4][2], const Unit& u, int wr, int wc, int fr, int fq) const {
        const int pn = u.pn; bf16_t* base; int ldc, colt, kind;
        if (pn < 6) { base = qkva; ldc = 1536; colt = pn * 256; kind = pn < 2 ? 1 : (pn < 4 ? 2 : 0); }
        else if (pn < 8) { base = za; ldc = 512; colt = (pn - 6) * 256; kind = 3; }
        else if (pn < 14) { base = qkvb; ldc = 1536; colt = (pn - 8) * 256; kind = 0; }
        else if (pn < 16) { base = zb; ldc = 512; colt = (pn - 14) * 256; kind = 3; }
        else { base = gate; ldc = 2048; colt = (pn - 16) * 256; kind = 4; }
        const int row0 = u.pm * BM + wr * 64 + fr; const int colw = colt + wc * 64 + 8 * fq;
        f32x4 gv[2][2];
#pragma unroll
        for (int bj = 0; bj < 2; ++bj)
#pragma unroll
            for (int n = 0; n < 2; ++n) gv[bj][n] = (f32x4){1.f, 1.f, 1.f, 1.f};
        if (kind == 1 || kind == 2) { const float* gp = (kind == 1) ? qg : kg; const float sc = (kind == 1) ? c2 : 1.0f;
#pragma unroll
            for (int bj = 0; bj < 2; ++bj)
#pragma unroll
                for (int n = 0; n < 2; ++n) gv[bj][n] = *(const f32x4*)(gp + 32 * bj + 8 * fq + 4 * n) * sc; }
#pragma unroll
        for (int ai = 0; ai < 2; ++ai)
#pragma unroll
            for (int m = 0; m < 4; ++m) { bf16_t* rowp = base + (size_t)(row0 + ai * HALF + m * 16) * ldc + colw;
                f32x4 v[2][2];
#pragma unroll
                for (int bj = 0; bj < 2; ++bj)
#pragma unroll
                    for (int n = 0; n < 2; ++n) v[bj][n] = acc[ai][bj][m][n];
                if (kind == 1 || kind == 2) {
                    float ss = 0.f;
#pragma unroll
                    for (int bj = 0; bj < 2; ++bj)
#pragma unroll
                        for (int n = 0; n < 2; ++n) { const f32x4 x = v[bj][n]; ss += (x[0] * x[0] + x[1] * x[1]) + (x[2] * x[2] + x[3] * x[3]); }
                    ss += __shfl_xor(ss, 16); ss += __shfl_xor(ss, 32);
                    const float rs = __builtin_amdgcn_rsqf(ss * (1.0f / 64.0f) + 1e-6f);
#pragma unroll
                    for (int bj = 0; bj < 2; ++bj)
#pragma unroll
                        for (int n = 0; n < 2; ++n) v[bj][n] = v[bj][n] * gv[bj][n] * rs;
                } else if (kind == 3) {
#pragma unroll
                    for (int bj = 0; bj < 2; ++bj)
#pragma unroll
                        for (int n = 0; n < 2; ++n)
#pragma unroll
                            for (int e = 0; e < 4; ++e) v[bj][n][e] = v[bj][n][e] * fast_sigmoid(v[bj][n][e]);
                } else if (kind == 4) {
#pragma unroll
                    for (int bj = 0; bj < 2; ++bj)
#pragma unroll
                        for (int n = 0; n < 2; ++n)
#pragma unroll
                            for (int e = 0; e < 4; ++e) v[bj][n][e] = fast_sigmoid(v[bj][n][e]);
                }
#pragma unroll
                for (int bj = 0; bj < 2; ++bj) { u32x4 w; w.x = cvt_pk_bf16(v[bj][0][0], v[bj][0][1]); w.y = cvt_pk_bf16(v[bj][0][2], v[bj][0][3]); w.z = cvt_pk_bf16(v[bj][1][0], v[bj][1][1]); w.w = cvt_pk_bf16(v[bj][1][2], v[bj][1][3]);
                    *(u32x4*)(rowp + bj * 32) = w; } }
    }
};
__device__ __forceinline__ float bf_lo(unsigned w) { return __uint_as_float(w << 16); }
__device__ __forceinline__ float bf_hi(unsigned w) { return __uint_as_float(w & 0xffff0000u); }
struct EpiGate {
    static constexpr bool PERM = true, AFTER_DRAIN = false;
    bf16_t* P; const bf16_t* gate; int ldc;
    __device__ __forceinline__ void operator()(const f32x4 (&acc)[2][2][4][2], const Unit& u, int wr, int wc, int fr, int fq) const {
        const int row0 = u.pm * BM + wr * 64 + fr; const int col0 = u.pn * BM + wc * 32 + 8 * fq;
#pragma unroll
        for (int ai = 0; ai < 2; ++ai)
#pragma unroll
            for (int m = 0; m < 4; ++m) { const size_t off = (size_t)(row0 + ai * HALF + m * 16) * ldc + col0;
#pragma unroll
                for (int bj = 0; bj < 2; ++bj) { const u32x4 g = *(const u32x4*)(gate + off + bj * HALF); const f32x4 v0 = acc[ai][bj][m][0], v1 = acc[ai][bj][m][1];
                    u32x4 w; w.x = cvt_pk_bf16(v0[0] * bf_lo(g.x), v0[1] * bf_hi(g.x)); w.y = cvt_pk_bf16(v0[2] * bf_lo(g.y), v0[3] * bf_hi(g.y));
                    w.z = cvt_pk_bf16(v1[0] * bf_lo(g.z), v1[1] * bf_hi(g.z)); w.w = cvt_pk_bf16(v1[2] * bf_lo(g.w), v1[3] * bf_hi(g.w));
                    *(u32x4*)(P + off + bj * HALF) = w; } }
    }
};
struct EpiOut {
    static constexpr bool PERM = false, AFTER_DRAIN = false;
    const float* x; float* out; int ldc;
    __device__ __forceinline__ void operator()(const f32x4 (&acc)[2][2][4][2], const Unit& u, int wr, int wc, int fr, int fq) const {
        const int row0 = u.pm * BM + wr * 64 + fr; const int col0 = u.pn * BM + wc * 32 + 4 * fq;
#pragma unroll
        for (int ai = 0; ai < 2; ++ai)
#pragma unroll
            for (int m = 0; m < 4; ++m) { const size_t off = (size_t)(row0 + ai * HALF + m * 16) * ldc + col0;
#pragma unroll
                for (int bj = 0; bj < 2; ++bj)
#pragma unroll
                    for (int n = 0; n < 2; ++n) { const f32x4 xv = *(const f32x4*)(x + off + bj * HALF + n * 16); *(f32x4*)(out + off + bj * HALF + n * 16) = xv + acc[ai][bj][m][n]; } }
    }
};
template <class Epi, class Sched, bool ALIGN_EPI = false, bool SP2 = false>
__device__ __forceinline__ void gemm_phase(PG8_LAS unsigned char* lds, const Gemm g, const Sched& S, const Epi& E) {
    const int tid = threadIdx.x, wid = __builtin_amdgcn_readfirstlane(tid >> 6), lane = tid & 63, wr = wid >> 2, wc = wid & 3, fr = lane & 15, fq = lane >> 4;
    const int K = g.K, nt = K / BK;
    unsigned voffA[2], voffB[2];
#pragma unroll
    for (int i = 0; i < 2; ++i) { int R, C; stage_rc(tid * 16 + i * 8192, R, C); const int Rb = Epi::PERM ? ((R & ~31) + perm32(R & 31)) : R;
        voffA[i] = (unsigned)(R * K + C) * 2u; voffB[i] = (unsigned)(Rb * K + C) * 2u; }
    const size_t kstep = (size_t)(BK * 2);
    const size_t hstep = (size_t)HALF * K * 2;
    const size_t tstep = 2 * hstep;
    const unsigned ldsw = (unsigned)wid * 1024u;
    const int aoff = lds_byte(wr * 64 + fr, fq * 8), boff = lds_byte(wc * 32 + fr, fq * 8);
#define PG8_SA(b, h) (((b) * 2 + (h)) * HTB)
#define PG8_SB(b, h) ((4 + (b) * 2 + (h)) * HTB)
#define PG8_STAGE(bufoff, gbase, voff) do { _Pragma("unroll") for (int _i = 0; _i < 2; ++_i) \
        __builtin_amdgcn_global_load_lds((const unsigned*)((const char*)(gbase) + (voff)[_i]), (PG8_LAS unsigned*)(lds + (bufoff) + ldsw + _i * 8192), 16, 0, 0); } while (0)
#define PG8_LDA(dst, b, h) do { _Pragma("unroll") for (int m = 0; m < 4; ++m) _Pragma("unroll") for (int k = 0; k < 2; ++k) dst[m][k] = *(const PG8_LAS bf16x8*)(lds + PG8_SA(b, h) + aoff + m * 2048 + k * 1024); } while (0)
#define PG8_LDB(dst, b, h) do { _Pragma("unroll") for (int n = 0; n < 2; ++n) _Pragma("unroll") for (int k = 0; k < 2; ++k) dst[n][k] = *(const PG8_LAS bf16x8*)(lds + PG8_SB(b, h) + boff + n * 2048 + k * 1024); } while (0)
#define PG8_MMA(ai, bj, At, Bt) do { __builtin_amdgcn_s_setprio(1); _Pragma("unroll") for (int m = 0; m < 4; ++m) _Pragma("unroll") for (int n = 0; n < 2; ++n) _Pragma("unroll") for (int k = 0; k < 2; ++k) \
        acc[ai][bj][m][n] = __builtin_amdgcn_mfma_f32_16x16x32_bf16(Bt[n][k], At[m][k], acc[ai][bj][m][n], 0, 0, 0); __builtin_amdgcn_s_setprio(0); } while (0)
#define PG8_WAIT_V(n) asm volatile("s_waitcnt vmcnt(" #n ")" ::: "memory")
#define PG8_WAIT_L(n) asm volatile("s_waitcnt lgkmcnt(" #n ")" ::: "memory")
#define PG8_BAR __builtin_amdgcn_s_barrier()
#define PG8_SCHED __builtin_amdgcn_sched_barrier(0)
    Unit cur, nxt; int ui = 0;
    if (!S.next(0, cur)) return;
    f32x4 acc[2][2][4][2];
#pragma unroll
    for (int a = 0; a < 2; ++a)
#pragma unroll
        for (int b = 0; b < 2; ++b)
#pragma unroll
            for (int m = 0; m < 4; ++m)
#pragma unroll
                for (int n = 0; n < 2; ++n) acc[a][b][m][n] = (f32x4){0.f, 0.f, 0.f, 0.f};
    bf16x8 At[4][2], B0[2][2], B1[2][2];
    const char* cA = (const char*)g.A + (size_t)cur.pm * tstep + S.a_off(cur); const char* cB = (const char*)g.Bt + (size_t)cur.pn * tstep;
    S.a_ready(cur);
    if constexpr (SP2) {
        PG8_STAGE(PG8_SB(0, 0), cB, voffB); PG8_STAGE(PG8_SB(0, 1), cB + hstep, voffB); PG8_STAGE(PG8_SA(0, 0), cA, voffA); PG8_STAGE(PG8_SA(0, 1), cA + hstep, voffA);
        if (wr == 1) PG8_BAR;
        PG8_WAIT_V(2); PG8_BAR;
        PG8_STAGE(PG8_SB(1, 0), cB + kstep, voffB); PG8_STAGE(PG8_SA(1, 0), cA + kstep, voffA); PG8_STAGE(PG8_SB(1, 1), cB + hstep + kstep, voffB);
        PG8_WAIT_V(6); PG8_BAR;
    } else {
        PG8_STAGE(PG8_SB(0, 0), cB, voffB); PG8_STAGE(PG8_SA(0, 0), cA, voffA); PG8_STAGE(PG8_SB(0, 1), cB + hstep, voffB); PG8_STAGE(PG8_SA(0, 1), cA + hstep, voffA);
        if (wr == 1) PG8_BAR;
        PG8_WAIT_V(4); PG8_BAR;
        PG8_STAGE(PG8_SB(1, 0), cB + kstep, voffB); PG8_STAGE(PG8_SA(1, 0), cA + kstep, voffA); PG8_STAGE(PG8_SB(1, 1), cB + hstep + kstep, voffB);
        PG8_WAIT_V(6); PG8_BAR;
    }
    for (;;) {
        const bool has_next = S.next(ui + 1, nxt);
        const char* nA = has_next ? (const char*)g.A + (size_t)nxt.pm * tstep + S.a_off(nxt) : cA; const char* nB = has_next ? (const char*)g.Bt + (size_t)nxt.pn * tstep : cB;
        for (int t = 0; t < nt; t += 2) {
            const bool last = (t == nt - 2);
            const char* a1 = cA + (size_t)(t + 1) * kstep;
            const char* a2 = last ? nA : cA + (size_t)(t + 2) * kstep; const char* b2 = last ? nB : cB + (size_t)(t + 2) * kstep;
            const char* a3 = a2 + kstep; const char* b3 = b2 + kstep;
            if (last && has_next) S.a_ready(nxt);
            if constexpr (SP2) {
            PG8_LDB(B0, 0, 0); PG8_LDB(B1, 0, 1); PG8_SCHED; PG8_LDA(At, 0, 0); PG8_STAGE(PG8_SA(1, 1), a1 + hstep, voffA);
            PG8_WAIT_V(8); PG8_WAIT_L(0); PG8_BAR; PG8_MMA(0, 0, At, B0); PG8_MMA(0, 1, At, B1); PG8_BAR; PG8_SCHED;
            PG8_LDA(At, 0, 1); PG8_STAGE(PG8_SB(0, 0), b2, voffB); PG8_STAGE(PG8_SB(0, 1), b2 + hstep, voffB); PG8_STAGE(PG8_SA(0, 0), a2, voffA);
            PG8_WAIT_V(8); PG8_WAIT_L(0); PG8_BAR; PG8_MMA(1, 0, At, B0); PG8_MMA(1, 1, At, B1); PG8_BAR; PG8_SCHED;
            PG8_LDB(B0, 1, 0); PG8_LDB(B1, 1, 1); PG8_SCHED; PG8_LDA(At, 1, 0); PG8_STAGE(PG8_SA(0, 1), a2 + hstep, voffA);
            PG8_WAIT_V(8); PG8_WAIT_L(0); PG8_BAR; PG8_MMA(0, 0, At, B0); PG8_MMA(0, 1, At, B1); PG8_BAR; PG8_SCHED;
            PG8_LDA(At, 1, 1); PG8_STAGE(PG8_SB(1, 0), b3, voffB); PG8_STAGE(PG8_SB(1, 1), b3 + hstep, voffB); PG8_STAGE(PG8_SA(1, 0), a3, voffA);
            PG8_WAIT_V(8); PG8_WAIT_L(0); PG8_BAR; PG8_MMA(1, 0, At, B0); PG8_MMA(1, 1, At, B1); PG8_BAR; PG8_SCHED;
            } else {
            PG8_LDB(B0, 0, 0); PG8_SCHED; PG8_LDA(At, 0, 0); PG8_STAGE(PG8_SA(1, 1), a1 + hstep, voffA);
            PG8_WAIT_L(8); PG8_BAR; PG8_WAIT_L(0); PG8_MMA(0, 0, At, B0); PG8_BAR; PG8_SCHED;
            PG8_LDB(B1, 0, 1); PG8_STAGE(PG8_SB(0, 0), b2, voffB);
            PG8_BAR; PG8_WAIT_L(0); PG8_MMA(0, 1, At, B1); PG8_BAR;
            PG8_LDA(At, 0, 1); PG8_STAGE(PG8_SA(0, 0), a2, voffA);
            PG8_BAR; PG8_WAIT_L(0); PG8_MMA(1, 0, At, B0); PG8_BAR; PG8_SCHED;
            PG8_STAGE(PG8_SB(0, 1), b2 + hstep, voffB);
            PG8_WAIT_V(6); PG8_BAR; PG8_MMA(1, 1, At, B1); PG8_BAR;
            PG8_LDB(B0, 1, 0); PG8_SCHED; PG8_LDA(At, 1, 0); PG8_STAGE(PG8_SA(0, 1), a2 + hstep, voffA);
            PG8_WAIT_L(8); PG8_BAR; PG8_WAIT_L(0); PG8_MMA(0, 0, At, B0); PG8_BAR; PG8_SCHED;
            PG8_LDB(B1, 1, 1); PG8_STAGE(PG8_SB(1, 0), b3, voffB);
            PG8_BAR; PG8_WAIT_L(0); PG8_MMA(0, 1, At, B1); PG8_BAR;
            PG8_LDA(At, 1, 1); PG8_STAGE(PG8_SA(1, 0), a3, voffA);
            PG8_BAR; PG8_WAIT_L(0); PG8_MMA(1, 0, At, B0); PG8_BAR; PG8_SCHED;
            PG8_STAGE(PG8_SB(1, 1), b3 + hstep, voffB);
            PG8_WAIT_V(6); PG8_BAR; PG8_MMA(1, 1, At, B1); PG8_BAR;
            }
        }
        if constexpr (ALIGN_EPI) { if (wr == 0) PG8_BAR; }
        if constexpr (!Epi::AFTER_DRAIN) { E(acc, cur, wr, wc, fr, fq); S.done(cur); }
        if (!has_next) break;
#pragma unroll
        for (int a = 0; a < 2; ++a)
#pragma unroll
            for (int b = 0; b < 2; ++b)
#pragma unroll
                for (int m = 0; m < 4; ++m)
#pragma unroll
                    for (int n = 0; n < 2; ++n) acc[a][b][m][n] = (f32x4){0.f, 0.f, 0.f, 0.f};
        cur = nxt; cA = nA; cB = nB; ++ui;
        if constexpr (ALIGN_EPI) { if (wr == 1) PG8_BAR; }
    }
    PG8_WAIT_V(0);
    if constexpr (!ALIGN_EPI) { if (wr == 0) PG8_BAR; }
    PG8_BAR;
    if constexpr (Epi::AFTER_DRAIN) { E.fused(acc, cur, wr, wc, fr, fq, lds, wid, lane); S.done(cur); }
#undef PG8_SA
#undef PG8_SB
#undef PG8_STAGE
#undef PG8_LDA
#undef PG8_LDB
#undef PG8_MMA
#undef PG8_WAIT_V
#undef PG8_WAIT_L
#undef PG8_BAR
#undef PG8_SCHED
}
}
#define GAS __attribute__((address_space(1)))
#define LAS __attribute__((address_space(3)))
typedef unsigned short bf16;
typedef unsigned v4u __attribute__((ext_vector_type(4)));
typedef float f32x4 __attribute__((ext_vector_type(4)));
typedef short bf16x8 __attribute__((ext_vector_type(8)));
typedef GAS unsigned gu32;
typedef GAS unsigned long long gu64;
#define RLX_AGENT __ATOMIC_RELAXED, __HIP_MEMORY_SCOPE_AGENT
#define LDS_WAIT() asm volatile("s_waitcnt lgkmcnt(0)" ::: "memory")
#define VM_WAIT() asm volatile("s_waitcnt vmcnt(0)" ::: "memory")
__device__ __forceinline__ unsigned long long rt() { return __builtin_amdgcn_s_memrealtime(); }
__device__ __forceinline__ unsigned f2bf(float f) { unsigned u = __builtin_bit_cast(unsigned, f); return (u + 0x7fffu + ((u >> 16) & 1u)) >> 16; }
__device__ __forceinline__ unsigned pk2(float lo, float hi) { return f2bf(lo) | (f2bf(hi) << 16); }
__device__ __forceinline__ float bf2f(bf16 v) { return __uint_as_float((unsigned)v << 16); }

#define XB_TMO      128
#define XB_XCNT(j)  (256  + 64 * (j))
#define XB_XSUB(j)  (1280 + 64 * (j))
#define XB_XGEN(j)  (2304 + 64 * (j))
#define XB_TOP      3328
#define XB_TOPGEN   3392
#define XCD_BAR_WORDS 3456
#define XB_SPIN_CAP (1u << 18)

__device__ __forceinline__ unsigned xb_ld(unsigned* p)              { return __hip_atomic_load(p, __ATOMIC_RELAXED, __HIP_MEMORY_SCOPE_AGENT); }
__device__ __forceinline__ unsigned xb_add(unsigned* p, unsigned v) { return __hip_atomic_fetch_add(p, v, __ATOMIC_RELAXED, __HIP_MEMORY_SCOPE_AGENT); }
__device__ __forceinline__ unsigned xb_xcc_id() { return (unsigned)__builtin_amdgcn_s_getreg((3 << 11) | 20) & 0xFu; }
#define XB_SPIN(cond, bar) do { unsigned _sp = 0; while (cond) { __builtin_amdgcn_s_sleep(1); \
    if ((++_sp & 255u) == 0u) { if (xb_ld(&(bar)[XB_TMO])) break; if (_sp > XB_SPIN_CAP) { atomicAdd(&(bar)[XB_TMO], 1u); break; } } } } while (0)

struct XcdBarrier {
    unsigned* bar; unsigned x;
    volatile LAS unsigned* st;
};

__device__ __forceinline__ XcdBarrier xcd_barrier_post(unsigned* bar, volatile LAS unsigned* st) {
    XcdBarrier b; b.bar = bar; b.x = xb_xcc_id(); b.st = st;
    if (threadIdx.x == 0) (void)xb_add(&bar[XB_XCNT(b.x)], 1u);
    return b;
}
__device__ __forceinline__ void xcd_barrier_complete(unsigned* bar, unsigned x, unsigned& nloc, unsigned& nx) {
    const unsigned G = gridDim.x * gridDim.y * gridDim.z;
    unsigned sum, cnt, mine, sp = 0u;
    for (;;) {
        sum = 0u; cnt = 0u; mine = 0u;
#pragma unroll
        for (unsigned j = 0; j < 16; ++j) { const unsigned c = xb_ld(&bar[XB_XCNT(j)]); sum += c; cnt += (c > 0u) ? 1u : 0u; mine = (j == x) ? c : mine; }
        if (sum == G) break;
        __builtin_amdgcn_s_sleep(1);
        if ((++sp & 255u) == 0u) { if (xb_ld(&bar[XB_TMO])) break; if (sp > XB_SPIN_CAP) { atomicAdd(&bar[XB_TMO], 1u); break; } }
    }
    nloc = mine > 0u ? mine : 1u; nx = cnt > 0u ? cnt : 1u;
}

__device__ __forceinline__ void xcd_barrier(const XcdBarrier& b) {
    asm volatile("s_waitcnt vmcnt(0)" ::: "memory");
    __syncthreads();
    if (threadIdx.x == 0) {
        unsigned* bar = b.bar;
        __builtin_amdgcn_s_waitcnt(0);
        unsigned nloc = b.st[0], nx = b.st[1];
        if (nloc == 0u) { xcd_barrier_complete(bar, b.x, nloc, nx); b.st[0] = nloc; b.st[1] = nx; }
        const unsigned old = xb_add(&bar[XB_XSUB(b.x)], 1u);
        const unsigned gen = old / nloc;
        if (old + 1u == (gen + 1u) * nloc) {
            __builtin_amdgcn_fence(__ATOMIC_RELEASE, "agent");
            asm volatile("s_waitcnt vmcnt(0)" ::: "memory");
            const unsigned og = xb_add(&bar[XB_TOP], 1u);
            const unsigned tg = og / nx;
            if (og + 1u == (tg + 1u) * nx) xb_add(&bar[XB_TOPGEN], 1u);
            else XB_SPIN(xb_ld(&bar[XB_TOPGEN]) == tg, bar);
            __builtin_amdgcn_fence(__ATOMIC_ACQUIRE, "agent");
            xb_add(&bar[XB_XGEN(b.x)], 1u);
            asm volatile("s_waitcnt vmcnt(0)" ::: "memory");
        } else {
            XB_SPIN(xb_ld(&bar[XB_XGEN(b.x)]) == gen, bar);
            __builtin_amdgcn_fence(__ATOMIC_ACQUIRE, "agent");
            asm volatile("s_waitcnt vmcnt(0)" ::: "memory");
        }
    }
    __syncthreads();
}
namespace da {
using bf16x8=__attribute__((ext_vector_type(8)))short;
using s16x4=__attribute__((ext_vector_type(4)))short;
using f32x16=__attribute__((ext_vector_type(16)))float;
using u32x4=__attribute__((ext_vector_type(4)))unsigned;
using f32x4=__attribute__((ext_vector_type(4)))float;
typedef unsigned short bf16_t;
#define DA_LAS __attribute__((address_space(3)))
constexpr int PQ=1536;
constexpr int KSLOT=16384, VSLOT=16384, SLOTB=KSLOT+VSLOT;
constexpr int OSTG=0;
constexpr int OROW=132;
__device__ __forceinline__ int crow(int r,int hi){return (r&3)+8*(r>>2)+4*hi;}
#define SBAR() __builtin_amdgcn_sched_barrier(0)
__device__ __forceinline__ void glds16(const void*gsrc,unsigned lds_dst){unsigned keep;
  asm volatile("s_mov_b32 %0, m0\n\ts_mov_b32 m0, %2\n\ts_nop 0\n\tglobal_load_lds_dwordx4 %1, off\n\ts_mov_b32 m0, %0":"=&s"(keep):"v"(gsrc),"s"(lds_dst):"memory");}
typedef float f32x2_t __attribute__((ext_vector_type(2))); typedef __bf16 bf16x2_t __attribute__((ext_vector_type(2)));
__device__ __forceinline__ unsigned cvtpk_s(float lo,float hi){f32x2_t v={lo,hi};bf16x2_t b=__builtin_convertvector(v,bf16x2_t);return __builtin_bit_cast(unsigned,b);}
__device__ __forceinline__ void qkt(f32x16&p0,f32x16&p1,const DA_LAS char*kb,const bf16x8*qr,const f32x16&negm){
  #pragma unroll
  for(int d0=0;d0<4;++d0){
    const bf16x8 b0=*(const DA_LAS bf16x8*)(kb+d0*2048);
    const bf16x8 b1=*(const DA_LAS bf16x8*)(kb+d0*2048+512);
    if(d0==0){p0=__builtin_amdgcn_mfma_f32_32x32x16_bf16(b0,qr[0],negm,0,0,0);p1=__builtin_amdgcn_mfma_f32_32x32x16_bf16(b1,qr[0],negm,0,0,0);}
    else{p0=__builtin_amdgcn_mfma_f32_32x32x16_bf16(b0,qr[d0],p0,0,0,0);p1=__builtin_amdgcn_mfma_f32_32x32x16_bf16(b1,qr[d0],p1,0,0,0);}}
}
__device__ __forceinline__ void pv(f32x16*o,int vb,bf16x8 pa0,bf16x8 pa1,bf16x8 pa2,bf16x8 pa3){
  #pragma unroll
  for(int eb=0;eb<4;++eb){s16x4 lo[4],hi[4];
    #pragma unroll
    for(int ks=0;ks<4;++ks){
      asm volatile("ds_read_b64_tr_b16 %0,%1 offset:%c2":"=&v"(lo[ks]):"v"(vb),"i"(eb*4096+ks*1024):"memory");
      asm volatile("ds_read_b64_tr_b16 %0,%1 offset:%c2":"=&v"(hi[ks]):"v"(vb),"i"(eb*4096+ks*1024+512):"memory");}
    asm volatile("s_waitcnt lgkmcnt(0)":::"memory");SBAR();
    #define PK(k) (bf16x8){lo[k][0],lo[k][1],lo[k][2],lo[k][3],hi[k][0],hi[k][1],hi[k][2],hi[k][3]}
    o[eb]=__builtin_amdgcn_mfma_f32_32x32x16_bf16(pa0,PK(0),o[eb],0,0,0);
    o[eb]=__builtin_amdgcn_mfma_f32_32x32x16_bf16(pa1,PK(1),o[eb],0,0,0);
    o[eb]=__builtin_amdgcn_mfma_f32_32x32x16_bf16(pa2,PK(2),o[eb],0,0,0);
    o[eb]=__builtin_amdgcn_mfma_f32_32x32x16_bf16(pa3,PK(3),o[eb],0,0,0);
    #undef PK
  }
}
struct Tensors { const bf16_t* qkv; const bf16_t* za; bf16_t* ya; const float* og; float lam; float negM; };
__device__ __forceinline__ void attn_unit(int b,int h,int j,const Tensors&T,DA_LAS char*shm){
  const int tid=threadIdx.x,lane=tid&63,r32=lane&31,hi=lane>>5; const int wid=__builtin_amdgcn_readfirstlane(tid>>6);
  const int qsub=wid&3,mp=wid>>2;
  const long rowbase=(long)b*8192; const int q0=j*128;
  const bf16_t*Qw=T.qkv+(rowbase+q0+qsub*32)*PQ+h*128+mp*64;
  const bf16_t*Kh=T.qkv+rowbase*PQ+512+h*128,*Vh=T.qkv+rowbase*PQ+1024+h*128;
  const unsigned lds0=(unsigned)(uintptr_t)shm;
  const int NT=2*j+2, NTw=2*j+1+(qsub>>1);
  const bf16_t*ksrc0=Kh+(long)lane*PQ+wid*8, *ksrc1=ksrc0+64;
  const bf16_t*vsrc0=Vh+(long)(16*(wid&3)+(lane>>2))*PQ+(wid>>2)*32+(lane&3)*8, *vsrc1=vsrc0+64;
  #define DMA_TILE(t,slot) do{ const long ro_=(long)(t)*64*PQ; const unsigned sb_=lds0+(slot)*SLOTB; \
     glds16(ksrc0+ro_,(unsigned)__builtin_amdgcn_readfirstlane(sb_+wid*1024)); glds16(ksrc1+ro_,(unsigned)__builtin_amdgcn_readfirstlane(sb_+(wid+8)*1024)); \
     glds16(vsrc0+ro_,(unsigned)__builtin_amdgcn_readfirstlane(sb_+KSLOT+wid*1024)); glds16(vsrc1+ro_,(unsigned)__builtin_amdgcn_readfirstlane(sb_+KSLOT+(wid+8)*1024)); }while(0)
  DMA_TILE(0,0);
  bf16x8 qr[4];
  #pragma unroll
  for(int d0=0;d0<4;++d0)qr[d0]=*reinterpret_cast<const bf16x8*>(&Qw[(long)r32*PQ+d0*16+hi*8]);
  float l_reg=0.f; f32x16 o[4]; o[0]=f32x16{};o[1]=f32x16{};o[2]=f32x16{};o[3]=f32x16{};
  f32x16 negm;
  #pragma unroll
  for(int r=0;r<16;++r)negm[r]=T.negM;
  const int vb0=(int)lds0+KSLOT+((lane>>4)&1)*32+(lane&3)*8+(4*hi+((lane&15)>>2))*64;
  const DA_LAS char*kp0=shm+mp*8192+hi*1024+r32*16;
  for(int t=0;t<NT;++t){
    const int sl=t&1;
    if(t+1<NT){ DMA_TILE(t+1,sl^1); asm volatile("s_waitcnt vmcnt(4) lgkmcnt(0)\n\ts_barrier":::"memory"); }
    else { asm volatile("s_waitcnt vmcnt(0) lgkmcnt(0)\n\ts_barrier":::"memory"); }
    if(t<NTw){
      f32x16 p0,p1;
      qkt(p0,p1,kp0+sl*SLOTB,qr,negm);
      #pragma unroll
      for(int r=0;r<16;++r){p0[r]=__builtin_amdgcn_exp2f(p0[r]);p1[r]=__builtin_amdgcn_exp2f(p1[r]);}
      float sacc=0.f;
      #pragma unroll
      for(int r=0;r<16;++r)sacc+=p0[r]+p1[r];
      l_reg+=sacc;
      u32x4 pw0,pw1,pw2,pw3;
      #define PKW(P,B) cvtpk_s(P[B],P[B+1])
      pw0=(u32x4){PKW(p0,0),PKW(p0,2),PKW(p0,4),PKW(p0,6)};pw1=(u32x4){PKW(p0,8),PKW(p0,10),PKW(p0,12),PKW(p0,14)};
      pw2=(u32x4){PKW(p1,0),PKW(p1,2),PKW(p1,4),PKW(p1,6)};pw3=(u32x4){PKW(p1,8),PKW(p1,10),PKW(p1,12),PKW(p1,14)};
      #undef PKW
      SBAR();
      pv(o,vb0+sl*SLOTB,__builtin_bit_cast(bf16x8,pw0),__builtin_bit_cast(bf16x8,pw1),__builtin_bit_cast(bf16x8,pw2),__builtin_bit_cast(bf16x8,pw3));
    }
    asm volatile("s_waitcnt lgkmcnt(0)\n\ts_barrier":::"memory");
  }
  #undef DMA_TILE
  {auto rr=__builtin_amdgcn_permlane32_swap(__float_as_uint(l_reg),__float_as_uint(l_reg),false,false);l_reg=__uint_as_float(rr[0])+__uint_as_float(rr[1]);}
  DA_LAS float*lsc=(DA_LAS float*)(shm+OSTG+4*32*OROW*4)+wid*32;
  DA_LAS float*stg=(DA_LAS float*)(shm+OSTG)+qsub*32*OROW;
  if(hi==0)lsc[r32]=l_reg; asm volatile("s_waitcnt lgkmcnt(0)":::"memory");
  float rli[16];
  #pragma unroll
  for(int r=0;r<16;++r)rli[r]=__builtin_amdgcn_rcpf(lsc[crow(r,hi)]);
  if(mp==1){
    #pragma unroll
    for(int r=0;r<16;++r){const int orow=crow(r,hi); const float f=rli[r]*T.lam;
      #pragma unroll
      for(int eb=0;eb<4;++eb)stg[orow*OROW+eb*32+r32]=o[eb][r]*f;}
  }
  asm volatile("s_waitcnt lgkmcnt(0)\n\ts_barrier":::"memory");
  if(mp==0){
    #pragma unroll
    for(int r=0;r<16;++r){const int orow=crow(r,hi);
      #pragma unroll
      for(int eb=0;eb<4;++eb){const float d=o[eb][r]*rli[r]-stg[orow*OROW+eb*32+r32]; o[eb][r]=d;}}
    asm volatile("s_waitcnt lgkmcnt(0)":::"memory");
    #pragma unroll
    for(int r=0;r<16;++r){const int orow=crow(r,hi);
      #pragma unroll
      for(int eb=0;eb<4;++eb)stg[orow*OROW+eb*32+r32]=o[eb][r];}
    asm volatile("s_waitcnt lgkmcnt(0)":::"memory");
    const int row=lane>>1,hf=lane&1; const DA_LAS float*rp=stg+row*OROW+hf*64;
    const long grow=rowbase+q0+qsub*32+row;
    const bf16_t*zp=T.za+grow*512+h*128+hf*64; bf16_t*yp=T.ya+grow*512+h*128+hf*64; const float*gp=T.og+hf*64;
    float ss=0.f;
    #pragma unroll
    for(int i=0;i<16;++i){const f32x4 v=*(const DA_LAS f32x4*)(rp+4*i); ss+=(v[0]*v[0]+v[1]*v[1])+(v[2]*v[2]+v[3]*v[3]);}
    ss+=__shfl_xor(ss,1);
    const float rs=__builtin_amdgcn_rsqf(ss*(1.0f/128.0f)+1e-6f)*0.8f;
    #pragma unroll
    for(int i=0;i<8;++i){const f32x4 v0=*(const DA_LAS f32x4*)(rp+8*i),v1=*(const DA_LAS f32x4*)(rp+8*i+4); const f32x4 g0=*(const f32x4*)(gp+8*i),g1=*(const f32x4*)(gp+8*i+4);
      const u32x4 z=*(const u32x4*)(zp+8*i);
      u32x4 w; w.x=cvtpk_s(v0[0]*rs*g0[0]*pg8::bf_lo(z.x),v0[1]*rs*g0[1]*pg8::bf_hi(z.x)); w.y=cvtpk_s(v0[2]*rs*g0[2]*pg8::bf_lo(z.y),v0[3]*rs*g0[3]*pg8::bf_hi(z.y));
      w.z=cvtpk_s(v1[0]*rs*g1[0]*pg8::bf_lo(z.z),v1[1]*rs*g1[1]*pg8::bf_hi(z.z)); w.w=cvtpk_s(v1[2]*rs*g1[2]*pg8::bf_lo(z.w),v1[3]*rs*g1[3]*pg8::bf_hi(z.w));
      *(u32x4*)(yp+8*i)=w;}
  }
  asm volatile("s_waitcnt lgkmcnt(0)\n\ts_barrier":::"memory");
}
#undef SBAR
}
constexpr int NWAVES = 8;
constexpr int BATCH = 2, T = 8192, D = 1024, M = BATCH * T;
constexpr int D_IN = 6152, NPROJ = 6144;
constexpr float EPS = 1e-6f;
constexpr float C2 = 0.125f * 1.4426950408889634f;

constexpr size_t MiB = 1u << 20;
constexpr size_t WS_CTL = 0, CTL_ZERO_BYTES = 1 * MiB;
constexpr size_t WS_WIN = 2 * MiB;
constexpr size_t WS_WUP = 14 * MiB;
constexpr size_t WS_WOUT = 16 * MiB;
constexpr size_t WS_GB = 20 * MiB;
constexpr size_t WS_XN = 32 * MiB;
constexpr size_t WS_YA = 32 * MiB, WS_YB = 48 * MiB;
constexpr size_t WS_QKVA = 64 * MiB;
constexpr size_t WS_ZA = 112 * MiB;
constexpr size_t WS_QKVB = 128 * MiB;
constexpr size_t WS_ZB = 176 * MiB;
constexpr size_t WS_GATE = 192 * MiB;
constexpr size_t WS_PBUF = 64 * MiB;
constexpr size_t WS_END = 256 * MiB;
constexpr int CW_BAR = 4096;

constexpr int RING_OFF = 0, RING_BYTES = 131072;
constexpr int LDSCTL_OFF = RING_BYTES, MISC_OFF = LDSCTL_OFF + 320;
constexpr int GX_OFF = 132096;
constexpr int LDS_BYTES = 163840;

struct Frame {
    LAS unsigned char* lds; volatile LAS unsigned* MISC; gu32* ctl;
    int tid, lane, wave, vcu, G;
};

__device__ __forceinline__ float wave_sum(float v) {
#pragma unroll
    for (int o = 1; o < 64; o <<= 1) v += __shfl_xor(v, o);
    return v;
}
__device__ __forceinline__ float wave_max(float v) {
#pragma unroll
    for (int o = 1; o < 64; o <<= 1) v = fmaxf(v, __shfl_xor(v, o));
    return v;
}
__device__ __forceinline__ void p0_transpose_item(const float* W, int ldw, int src_n0, int k0, bf16* WT, int ldt, int dst_row0, int dst_k0, LAS float* scr, int lane) {
#pragma unroll 8
    for (int i = 0; i < 32; ++i) { const int kk = 2 * i + (lane >> 5); scr[kk * 33 + (lane & 31)] = W[(size_t)(k0 + kk) * ldw + src_n0 + (lane & 31)]; }
    LDS_WAIT(); asm volatile("" ::: "memory");
    const int c = lane & 7;
#pragma unroll
    for (int j = 0; j < 4; ++j) { const int n = (lane >> 3) + 8 * j; const LAS float* s = scr + (8 * c) * 33 + n;
        v4u o; o.x = pk2(s[0 * 33], s[1 * 33]); o.y = pk2(s[2 * 33], s[3 * 33]); o.z = pk2(s[4 * 33], s[5 * 33]); o.w = pk2(s[6 * 33], s[7 * 33]);
        *(GAS v4u*)(WT + (size_t)(dst_row0 + n) * ldt + dst_k0 + k0 + 8 * c) = o; }
    LDS_WAIT(); asm volatile("" ::: "memory");
}

struct Args { const float* in[14]; float* out; unsigned char* ws; };

__device__ __forceinline__ void p0_prologue(Frame& F, const Args& A) {
    const float* x = A.in[0]; const float* norm_w = A.in[1]; const float* w_in = A.in[2];
    const float* a_log = A.in[8]; const float* dt_bias = A.in[9];
    const float* w_upa = A.in[11]; const float* w_upb = A.in[12]; const float* w_out = A.in[13];
    bf16* WIN = (bf16*)(A.ws + WS_WIN); bf16* WUP = (bf16*)(A.ws + WS_WUP); bf16* WOUT = (bf16*)(A.ws + WS_WOUT); bf16* XN = (bf16*)(A.ws + WS_XN);
    float* GB = (float*)(A.ws + WS_GB);
    LAS float* wab = (LAS float*)(F.lds + RING_OFF + 98304);
    for (int i = F.tid; i < 1024 * 8; i += NWAVES * 64) { const int k = i >> 3, j = i & 7; wab[i] = w_in[(size_t)k * D_IN + 4096 + j] * norm_w[k]; }
    LAS float* scr = (LAS float*)(F.lds + RING_OFF + F.wave * 8704);
    const int gw = F.vcu * NWAVES + F.wave, NGW = F.G * NWAVES;
    constexpr int I_IN = 16 * 192, I_UP = 8 * 32, I_OUT = 16 * 32; constexpr int NITEMS = I_IN + 2 * I_UP + I_OUT;
    for (int it = gw; it < NITEMS; it += NGW) {
        int r = it;
        if (r < I_IN) { const int kb = r / 192, nb = r % 192; const int n0 = nb * 32;
            const int src = n0 + (n0 >= 4096 ? 8 : 0); const int tt = n0 & 255; const int pos = (n0 & ~255) + 128 * ((tt >> 5) & 1) + 32 * (tt >> 6);
            p0_transpose_item(w_in, D_IN, src, kb * 64, WIN, 1024, pos, 0, scr, F.lane); continue; } r -= I_IN;
        if (r < I_UP) { const int kb = r / 32, nb = r % 32; p0_transpose_item(w_upa, 1024, nb * 32, kb * 64, WUP, 512, nb * 32, 0, scr, F.lane); continue; } r -= I_UP;
        if (r < I_UP) { const int kb = r / 32, nb = r % 32; p0_transpose_item(w_upb, 1024, nb * 32, kb * 64, WUP, 512, 1024 + nb * 32, 0, scr, F.lane); continue; } r -= I_UP;
        { const int kb = r / 32, nb = r % 32; p0_transpose_item(w_out, 1024, nb * 32, kb * 64, WOUT, 2048, nb * 32, 0, scr, F.lane);
          p0_transpose_item(w_out, 1024, nb * 32, kb * 64, WOUT, 2048, nb * 32, 1024, scr, F.lane); }
    }
    __syncthreads();
    f32x4 nw[4];
#pragma unroll
    for (int j = 0; j < 4; ++j) nw[j] = *((const GAS f32x4*)norm_w + F.lane + 64 * j);
    for (int m = gw; m < M; m += NGW) {
        const GAS f32x4* xr = (const GAS f32x4*)(x + (size_t)m * D) + F.lane;
        f32x4 v[4]; float s2 = 0.f;
#pragma unroll
        for (int j = 0; j < 4; ++j) { v[j] = xr[64 * j]; s2 += (v[j].x * v[j].x + v[j].y * v[j].y) + (v[j].z * v[j].z + v[j].w * v[j].w); }
        const float rstd = 1.f / sqrtf(wave_sum(s2) * (1.f / D) + EPS);
        GAS unsigned long long* o8 = (GAS unsigned long long*)(XN + (size_t)m * D) + F.lane;
        float ab[8];
#pragma unroll
        for (int q = 0; q < 8; ++q) ab[q] = 0.f;
#pragma unroll
        for (int j = 0; j < 4; ++j) {
            const f32x4 hn = v[j] * rstd;
            const f32x4 h = hn * nw[j];
            o8[64 * j] = (unsigned long long)pk2(h.x, h.y) | ((unsigned long long)pk2(h.z, h.w) << 32);
#pragma unroll
            for (int e = 0; e < 4; ++e) { const int k = 4 * F.lane + 256 * j + e; const f32x4 w0 = *(const LAS f32x4*)(wab + k * 8), w1 = *(const LAS f32x4*)(wab + k * 8 + 4);
                const float hv = hn[e];
                ab[0] += hv * w0.x; ab[1] += hv * w0.y; ab[2] += hv * w0.z; ab[3] += hv * w0.w; ab[4] += hv * w1.x; ab[5] += hv * w1.y; ab[6] += hv * w1.z; ab[7] += hv * w1.w; }
        }
#pragma unroll
        for (int q = 0; q < 8; ++q) ab[q] = wave_sum(ab[q]);
        if (F.lane < 8) { float val = ab[0];
#pragma unroll
            for (int q = 1; q < 8; ++q) val = (F.lane == q) ? ab[q] : val;
            float res;
            if (F.lane < 4) { const float xx = val + dt_bias[F.lane]; const float sp = xx > 20.f ? xx : log1pf(expf(xx)); res = -expf(a_log[F.lane]) * sp; }
            else res = 1.f / (1.f + expf(-val));
            GB[(size_t)m * 8 + F.lane] = res; }
    }
}

__device__ __forceinline__ void gdn_seq(Frame& F, const Args& A, int b, int h) {
    const bf16* QKVB = (const bf16*)(A.ws + WS_QKVB); const bf16* ZB = (const bf16*)(A.ws + WS_ZB); bf16* YB = (bf16*)(A.ws + WS_YB);
    const float* GB = (const float*)(A.ws + WS_GB); const float* conv_w = A.in[7]; const float* gnw = A.in[10];
    LAS float* qs = (LAS float*)(F.lds + RING_OFF);
    LAS float* ks = qs + 64 * 128;
    LAS float* vs = ks + 64 * 128;
    LAS float* os = vs + 64 * 128;
    LAS float* abs_ = (LAS float*)(F.lds + GX_OFF);
    const int tid = F.tid, lane = F.lane, w = F.wave;
    const int e = 16 * w + (lane & 15), part = lane >> 4;
    float S[32];
#pragma unroll
    for (int i = 0; i < 32; ++i) S[i] = 0.f;
    const size_t rowbase = (size_t)b * T;
    for (int n = 0; n < T / 64; ++n) {
        const int t0 = n * 64;
        if (tid < 384) {
            const int kind = tid >> 7, cc = tid & 127; const int col = kind * 512 + h * 128 + cc;
            const float w0 = conv_w[0 * 1536 + col], w1 = conv_w[1 * 1536 + col], w2 = conv_w[2 * 1536 + col], w3 = conv_w[3 * 1536 + col];
            float x0 = 0.f, x1 = 0.f, x2 = 0.f;
            if (t0 > 0) { const bf16* p = QKVB + (rowbase + t0 - 3) * 1536 + col; x0 = bf2f(p[0]); x1 = bf2f(p[1536]); x2 = bf2f(p[2 * 1536]); }
            LAS float* dst = (kind == 0 ? qs : (kind == 1 ? ks : vs)) + cc;
            const bf16* p = QKVB + (rowbase + t0) * 1536 + col;
#pragma unroll 8
            for (int t = 0; t < 64; ++t) { const float x3 = bf2f(p[(size_t)t * 1536]); const float y = w0 * x0 + w1 * x1 + w2 * x2 + w3 * x3;
                dst[t * 128] = y * pg8::fast_sigmoid(y); x0 = x1; x1 = x2; x2 = x3; }
        } else if (tid < 448) { const int t = tid - 384; const float g = GB[(rowbase + t0 + t) * 8 + h], be = GB[(rowbase + t0 + t) * 8 + 4 + h]; abs_[2 * t] = expf(g); abs_[2 * t + 1] = be; }
        __syncthreads();
        { const int pr = tid >> 2, sub = tid & 3; const int t = pr & 63, kind = pr >> 6; LAS float* rp = (kind == 0 ? qs : ks) + t * 128 + sub * 32;
          float ss = 0.f;
#pragma unroll
          for (int i = 0; i < 32; ++i) ss += rp[i] * rp[i];
          ss += __shfl_xor(ss, 1); ss += __shfl_xor(ss, 2);
          const float sc = (1.0f / sqrtf(ss + EPS)) * (kind == 0 ? 0.08838834764831845f : 1.0f);
#pragma unroll
          for (int i = 0; i < 32; ++i) rp[i] *= sc; }
        __syncthreads();
        for (int t = 0; t < 64; ++t) {
            const float a = abs_[2 * t], be = abs_[2 * t + 1];
            const LAS f32x4* kp = (const LAS f32x4*)(ks + t * 128 + part * 32); const LAS f32x4* qp = (const LAS f32x4*)(qs + t * 128 + part * 32);
            float r = 0.f; f32x4 kv[8];
#pragma unroll
            for (int i = 0; i < 8; ++i) { kv[i] = kp[i]; r += (kv[i].x * S[4 * i] + kv[i].y * S[4 * i + 1]) + (kv[i].z * S[4 * i + 2] + kv[i].w * S[4 * i + 3]); }
            r += __shfl_xor(r, 16); r += __shfl_xor(r, 32);
            const float dl = be * (vs[t * 128 + e] - a * r);
            float o = 0.f;
#pragma unroll
            for (int i = 0; i < 8; ++i) { const f32x4 qv = qp[i];
                S[4 * i] = a * S[4 * i] + kv[i].x * dl; S[4 * i + 1] = a * S[4 * i + 1] + kv[i].y * dl; S[4 * i + 2] = a * S[4 * i + 2] + kv[i].z * dl; S[4 * i + 3] = a * S[4 * i + 3] + kv[i].w * dl;
                o += (qv.x * S[4 * i] + qv.y * S[4 * i + 1]) + (qv.z * S[4 * i + 2] + qv.w * S[4 * i + 3]); }
            o += __shfl_xor(o, 16); o += __shfl_xor(o, 32);
            if (part == 0) os[t * 128 + e] = o;
        }
        __syncthreads();
        { const int t = tid >> 3, sg = tid & 7; const LAS float* op = os + t * 128 + sg * 16; float vv[16]; float ss = 0.f;
#pragma unroll
          for (int i = 0; i < 16; ++i) { vv[i] = op[i]; ss += vv[i] * vv[i]; }
          ss += __shfl_xor(ss, 1); ss += __shfl_xor(ss, 2); ss += __shfl_xor(ss, 4);
          const float rs = 1.0f / sqrtf(ss * (1.0f / 128.0f) + EPS);
          const size_t row = rowbase + t0 + t; const bf16* zp = ZB + row * 512 + h * 128 + sg * 16; bf16* yp = YB + row * 512 + h * 128 + sg * 16;
          unsigned ow[8];
#pragma unroll
          for (int i = 0; i < 8; ++i) { const float y0 = vv[2 * i] * rs * gnw[sg * 16 + 2 * i] * bf2f(zp[2 * i]), y1 = vv[2 * i + 1] * rs * gnw[sg * 16 + 2 * i + 1] * bf2f(zp[2 * i + 1]); ow[i] = pk2(y0, y1); }
          *(GAS v4u*)(yp) = (v4u){ow[0], ow[1], ow[2], ow[3]}; *(GAS v4u*)(yp + 8) = (v4u){ow[4], ow[5], ow[6], ow[7]}; }
        __syncthreads();
    }
}

__global__ void __launch_bounds__(NWAVES * 64, 2) hyb_fwd(Args args) {
    extern __shared__ __attribute__((aligned(16))) unsigned char lds[];
    Frame F;
    F.lds = (LAS unsigned char*)lds;
    F.MISC = (volatile LAS unsigned*)(F.lds + MISC_OFF);
    F.tid = threadIdx.x; F.lane = F.tid & 63; F.wave = __builtin_amdgcn_readfirstlane(F.tid >> 6);
    F.G = gridDim.x; { const int bx = blockIdx.x; F.vcu = (F.G % 8 == 0) ? (bx % 8) * (F.G / 8) + bx / 8 : bx; }
    unsigned char* ws = args.ws;
    F.ctl = (gu32*)(ws + WS_CTL);
    for (int u = F.tid; u < (GX_OFF - LDSCTL_OFF) / 4; u += NWAVES * 64) ((LAS unsigned*)(F.lds + LDSCTL_OFF))[u] = 0u;
    __syncthreads();
    XcdBarrier bar = xcd_barrier_post((unsigned*)(F.ctl + CW_BAR), F.MISC + 8);

    p0_prologue(F, args);
    xcd_barrier(bar);

    {
        pg8::Gemm g{(const pg8::bf16_t*)(ws + WS_XN), (const pg8::bf16_t*)(ws + WS_WIN), M, NPROJ, D}; pg8::StaticOrder S; S.init(M, NPROJ, F.G, (int)blockIdx.x);
        pg8::EpiProj E{(pg8::bf16_t*)(ws + WS_QKVA), (pg8::bf16_t*)(ws + WS_ZA), (pg8::bf16_t*)(ws + WS_QKVB), (pg8::bf16_t*)(ws + WS_ZB), (pg8::bf16_t*)(ws + WS_GATE), args.in[3], args.in[4], C2};
        pg8::gemm_phase<pg8::EpiProj, pg8::StaticOrder, true, true>(F.lds + RING_OFF, g, S, E);
    }
    xcd_barrier(bar);

    {
        if (F.vcu < 8) gdn_seq(F, args, F.vcu >> 2, F.vcu & 3);
        const float* lamp = args.in[5];
        const float l01 = wave_sum(lamp[F.lane] * lamp[64 + F.lane]), l23 = wave_sum(lamp[128 + F.lane] * lamp[192 + F.lane]);
        const float lam = expf(l01) - expf(l23) + 0.2f;
        const float mq = wave_max(fabsf(args.in[3][F.lane])), mk = wave_max(fabsf(args.in[4][F.lane]));
        const float negM = -(8.0f * 1.4426950408889634f * mq * mk);
        da::Tensors TT{(const da::bf16_t*)(ws + WS_QKVA), (const da::bf16_t*)(ws + WS_ZA), (da::bf16_t*)(ws + WS_YA), args.in[6], lam, negM};
        const int bh = F.vcu >> 5, s = F.vcu & 31;
        if (F.G == 256) {
            da::attn_unit(bh >> 2, bh & 3, 63 - s, TT, (LAS char*)(F.lds + RING_OFF));
            da::attn_unit(bh >> 2, bh & 3, s, TT, (LAS char*)(F.lds + RING_OFF));
        }
    }
    xcd_barrier(bar);

    {
        pg8::Gemm g{(const pg8::bf16_t*)(ws + WS_YA), (const pg8::bf16_t*)(ws + WS_WUP), M, 2048, 512}; pg8::StaticOrder S; S.init(M, 2048, F.G, (int)blockIdx.x);
        S.aoff_bytes = WS_YB - WS_YA; S.aoff_pn = 4;
        pg8::EpiGate E{(pg8::bf16_t*)(ws + WS_PBUF), (const pg8::bf16_t*)(ws + WS_GATE), 2048};
        pg8::gemm_phase<pg8::EpiGate, pg8::StaticOrder, true, true>(F.lds + RING_OFF, g, S, E);
    }
    xcd_barrier(bar);

    {
        pg8::Gemm g{(const pg8::bf16_t*)(ws + WS_PBUF), (const pg8::bf16_t*)(ws + WS_WOUT), M, D, 2048}; pg8::StaticOrder S; S.init(M, D, F.G, (int)blockIdx.x);
        pg8::EpiOut E{args.in[0], args.out, D};
        pg8::gemm_phase<pg8::EpiOut, pg8::StaticOrder, true, true>(F.lds + RING_OFF, g, S, E);
    }
}

extern "C" void kernel_launch(void* const* d_in, const int* in_sizes, int n_in, void* d_out, int out_size, void* d_ws, size_t ws_size, hipStream_t stream) {
    static int grid = 0;
    if (grid == 0) {
        if (n_in != 14 || in_sizes[0] != M * D || out_size != M * D || ws_size < WS_END) { fprintf(stderr, "kernel_launch: unexpected shapes (n_in %d, in0 %d, out %d, ws %zu); nothing launched\n", n_in, n_in > 0 ? in_sizes[0] : -1, out_size, ws_size); grid = -1; return; }
        int dev = 0, cus = 0, per_cu = 0;
        if (hipGetDevice(&dev) != hipSuccess || hipDeviceGetAttribute(&cus, hipDeviceAttributeMultiprocessorCount, dev) != hipSuccess) { grid = -1; return; }
        if (hipFuncSetAttribute((const void*)hyb_fwd, hipFuncAttributeMaxDynamicSharedMemorySize, LDS_BYTES) != hipSuccess) { fprintf(stderr, "kernel_launch: hipFuncSetAttribute failed\n"); grid = -1; return; }
        if (hipOccupancyMaxActiveBlocksPerMultiprocessor(&per_cu, (const void*)hyb_fwd, NWAVES * 64, LDS_BYTES) != hipSuccess || per_cu < 1) { fprintf(stderr, "kernel_launch: occupancy query reports %d workgroups per CU\n", per_cu); per_cu = 1; }
        (void)hipGetLastError();
        grid = cus;
    }
    if (grid < 0) return;
    if (hipMemsetAsync((char*)d_ws + WS_CTL, 0, CTL_ZERO_BYTES, stream) != hipSuccess) return;
    Args a{};
    for (int i = 0; i < 14; ++i) a.in[i] = (const float*)d_in[i];
    a.out = (float*)d_out; a.ws = (unsigned char*)d_ws;
    hipLaunchKernelGGL(hyb_fwd, dim3(grid), dim3(NWAVES * 64), LDS_BYTES, stream, a);
}
```

```cpp
#include <hip/hip_runtime.h>
#include <cstdio>
#include <cstdint>
#include <cmath>
namespace pg8 {
#define PG8_LAS __attribute__((address_space(3)))
typedef unsigned short bf16_t;
typedef short bf16x8 __attribute__((ext_vector_type(8)));
typedef float f32x4 __attribute__((ext_vector_type(4)));
typedef unsigned u32x4 __attribute__((ext_vector_type(4)));
constexpr int BM = 256, BK = 64, HALF = 128, HTB = HALF * BK * 2  , STAGE_BYTES = 8 * HTB, NXCD = 8, WGM = 8;

__host__ __device__ __forceinline__ int lds_byte(int r, int c) { const int st = (r >> 4) * 2 + (c >> 5), rr = r & 15, cc = c & 31, ob = rr * 64 + cc * 2; return st * 1024 + (ob ^ (((ob >> 9) & 1) << 5)); }
__host__ __device__ __forceinline__ void stage_rc(int b, int& R, int& C) { const int st = b / 1024, sb = b % 1024, swz = sb ^ (((sb >> 9) & 1) << 5); R = (st >> 1) * 16 + swz / 64; C = (st & 1) * 32 + (swz % 64) / 2; }
__host__ __device__ __forceinline__ int perm32(int rho) { const int n = rho >> 4, i = rho & 15; return 8 * (i >> 2) + 4 * n + (i & 3); }

struct Unit { int pm, pn; };
struct Gemm { const bf16_t* A; const bf16_t* Bt; int M, N, K; };

struct StaticOrder {
    int nM, nN, nwg, G, c;
    __host__ __device__ void init(int M, int N, int G_, int c_) { nM = M / BM; nN = N / BM; nwg = nM * nN; G = G_; c = c_; aoff_bytes = 0; aoff_pn = 1 << 30; }
    __host__ __device__ bool next(int i, Unit& u) const {
        const long L = (long)i * G + c; if (L >= nwg) return false;
        int wgid = (int)L; { const int q = nwg / NXCD, r = nwg % NXCD, xcd = wgid % NXCD, off = wgid / NXCD; wgid = (xcd < r ? xcd * (q + 1) : r * (q + 1) + (xcd - r) * q) + off; }
        const int nig = WGM * nN, gid = wgid / nig, fm = gid * WGM, gsz = (nM - fm) < WGM ? (nM - fm) : WGM;
        u.pm = fm + ((wgid % nig) % gsz); u.pn = (wgid % nig) / gsz; return true;
    }
    size_t aoff_bytes; int aoff_pn;
    __device__ __forceinline__ size_t a_off(const Unit& u) const { return u.pn >= aoff_pn ? aoff_bytes : (size_t)0; }
    __device__ __forceinline__ void a_ready(const Unit&) const {}
    __device__ __forceinline__ void done(const Unit&) const {}
};

__device__ __forceinline__ unsigned cvt_pk_bf16(float lo, float hi) { unsigned r; asm volatile("v_cvt_pk_bf16_f32 %0, %1, %2" : "=v"(r) : "v"(lo), "v"(hi)); return r; }
typedef float f32x2 __attribute__((ext_vector_type(2)));
__device__ __forceinline__ float fast_sigmoid(float x) { return __builtin_amdgcn_rcpf(1.0f + __builtin_amdgcn_exp2f(-1.4426950408889634f * x)); }
struct EpiProj {
    static constexpr bool PERM = true, AFTER_DRAIN = false;
    bf16_t *qkva, *za, *qkvb, *zb, *gate; const float *qg, *kg; float c2;
    __device__ __forceinline__ void operator()(const f32x4 (&acc)[2][2][4][2], const Unit& u, int wr, int wc, int fr, int fq) const {
        const int pn = u.pn; bf16_t* base; int ldc, colt, kind;
        if (pn < 6) { base = qkva; ldc = 1536; colt = pn * 256; kind = pn < 2 ? 1 : (pn < 4 ? 2 : 0); }
        else if (pn < 8) { base = za; ldc = 512; colt = (pn - 6) * 256; kind = 3; }
        else if (pn < 14) { base = qkvb; ldc = 1536; colt = (pn - 8) * 256; kind = 0; }
        else if (pn < 16) { base = zb; ldc = 512; colt = (pn - 14) * 256; kind = 3; }
        else { base = gate; ldc = 2048; colt = (pn - 16) * 256; kind = 4; }
        const int row0 = u.pm * BM + wr * 64 + fr; const int colw = colt + wc * 64 + 8 * fq;
        f32x4 gv[2][2];
#pragma unroll
        for (int bj = 0; bj < 2; ++bj)
#pragma unroll
            for (int n = 0; n < 2; ++n) gv[bj][n] = (f32x4){1.f, 1.f, 1.f, 1.f};
        if (kind == 1 || kind == 2) { const float* gp = (kind == 1) ? qg : kg; const float sc = (kind == 1) ? c2 : 1.0f;
#pragma unroll
            for (int bj = 0; bj < 2; ++bj)
#pragma unroll
                for (int n = 0; n < 2; ++n) gv[bj][n] = *(const f32x4*)(gp + 32 * bj + 8 * fq + 4 * n) * sc; }
#pragma unroll
        for (int ai = 0; ai < 2; ++ai)
#pragma unroll
            for (int m = 0; m < 4; ++m) { bf16_t* rowp = base + (size_t)(row0 + ai * HALF + m * 16) * ldc + colw;
                f32x4 v[2][2];
#pragma unroll
                for (int bj = 0; bj < 2; ++bj)
#pragma unroll
                    for (int n = 0; n < 2; ++n) v[bj][n] = acc[ai][bj][m][n];
                if (kind == 1 || kind == 2) {
                    float ss = 0.f;
#pragma unroll
                    for (int bj = 0; bj < 2; ++bj)
#pragma unroll
                        for (int n = 0; n < 2; ++n) { const f32x4 x = v[bj][n]; ss += (x[0] * x[0] + x[1] * x[1]) + (x[2] * x[2] + x[3] * x[3]); }
                    ss += __shfl_xor(ss, 16); ss += __shfl_xor(ss, 32);
                    const float rs = __builtin_amdgcn_rsqf(ss * (1.0f / 64.0f) + 1e-6f);
#pragma unroll
                    for (int bj = 0; bj < 2; ++bj)
#pragma unroll
                        for (int n = 0; n < 2; ++n) v[bj][n] = v[bj][n] * gv[bj][n] * rs;
                } else if (kind == 3) {
#pragma unroll
                    for (int bj = 0; bj < 2; ++bj)
#pragma unroll
                        for (int n = 0; n < 2; ++n)
#pragma unroll
                            for (int e = 0; e < 4; ++e) v[bj][n][e] = v[bj][n][e] * fast_sigmoid(v[bj][n][e]);
                } else if (kind == 4) {
#pragma unroll
                    for (int bj = 0; bj < 2; ++bj)
#pragma unroll
                        for (int n = 0; n < 2; ++n)
#pragma unroll
                            for (int e = 0; e < 4; ++e) v[bj][n][e] = fast_sigmoid(v[bj][n][e]);
                }
#pragma unroll
                for (int bj = 0; bj < 2; ++bj) { u32x4 w; w.x = cvt_pk_bf16(v[bj][0][0], v[bj][0][1]); w.y = cvt_pk_bf16(v[bj][0][2], v[bj][0][3]); w.z = cvt_pk_bf16(v[bj][1][0], v[bj][1][1]); w.w = cvt_pk_bf16(v[bj][1][2], v[bj][1][3]);
                    *(u32x4*)(rowp + bj * 32) = w; } }
    }
};
__device__ __forceinline__ float bf_lo(unsigned w) { return __uint_as_float(w << 16); }
__device__ __forceinline__ float bf_hi(unsigned w) { return __uint_as_float(w & 0xffff0000u); }
struct EpiGate {
    static constexpr bool PERM = true, AFTER_DRAIN = false;
    bf16_t* P; const bf16_t* gate; int ldc;
    __device__ __forceinline__ void operator()(const f32x4 (&acc)[2][2][4][2], const Unit& u, int wr, int wc, int fr, int fq) const {
        const int row0 = u.pm * BM + wr * 64 + fr; const int col0 = u.pn * BM + wc * 32 + 8 * fq;
#pragma unroll
        for (int ai = 0; ai < 2; ++ai)
#pragma unroll
            for (int m = 0; m < 4; ++m) { const size_t off = (size_t)(row0 + ai * HALF + m * 16) * ldc + col0;
#pragma unroll
                for (int bj = 0; bj < 2; ++bj) { const u32x4 g = *(const u32x4*)(gate + off + bj * HALF); const f32x4 v0 = acc[ai][bj][m][0], v1 = acc[ai][bj][m][1];
                    u32x4 w; w.x = cvt_pk_bf16(v0[0] * bf_lo(g.x), v0[1] * bf_hi(g.x)); w.y = cvt_pk_bf16(v0[2] * bf_lo(g.y), v0[3] * bf_hi(g.y));
                    w.z = cvt_pk_bf16(v1[0] * bf_lo(g.z), v1[1] * bf_hi(g.z)); w.w = cvt_pk_bf16(v1[2] * bf_lo(g.w), v1[3] * bf_hi(g.w));
                    *(u32x4*)(P + off + bj * HALF) = w; } }
    }
};
struct EpiOut {
    static constexpr bool PERM = false, AFTER_DRAIN = false;
    const float* x; float* out; int ldc;
    __device__ __forceinline__ void operator()(const f32x4 (&acc)[2][2][4][2], const Unit& u, int wr, int wc, int fr, int fq) const {
        const int row0 = u.pm * BM + wr * 64 + fr; const int col0 = u.pn * BM + wc * 32 + 4 * fq;
#pragma unroll
        for (int ai = 0; ai < 2; ++ai)
#pragma unroll
            for (int m = 0; m < 4; ++m) { const size_t off = (size_t)(row0 + ai * HALF + m * 16) * ldc + col0;
#pragma unroll
                for (int bj = 0; bj < 2; ++bj)
#pragma unroll
                    for (int n = 0; n < 2; ++n) { const f32x4 xv = *(const f32x4*)(x + off + bj * HALF + n * 16); *(f32x4*)(out + off + bj * HALF + n * 16) = xv + acc[ai][bj][m][n]; } }
    }
};
template <class Epi, class Sched, bool ALIGN_EPI = false, bool SP2 = false>
__device__ __forceinline__ void gemm_phase(PG8_LAS unsigned char* lds, const Gemm g, const Sched& S, const Epi& E) {
    const int tid = threadIdx.x, wid = __builtin_amdgcn_readfirstlane(tid >> 6), lane = tid & 63, wr = wid >> 2, wc = wid & 3, fr = lane & 15, fq = lane >> 4;
    const int K = g.K, nt = K / BK;
    unsigned voffA[2], voffB[2];
#pragma unroll
    for (int i = 0; i < 2; ++i) { int R, C; stage_rc(tid * 16 + i * 8192, R, C); const int Rb = Epi::PERM ? ((R & ~31) + perm32(R & 31)) : R;
        voffA[i] = (unsigned)(R * K + C) * 2u; voffB[i] = (unsigned)(Rb * K + C) * 2u; }
    const size_t kstep = (size_t)(BK * 2);
    const size_t hstep = (size_t)HALF * K * 2;
    const size_t tstep = 2 * hstep;
    const unsigned ldsw = (unsigned)wid * 1024u;
    const int aoff = lds_byte(wr * 64 + fr, fq * 8), boff = lds_byte(wc * 32 + fr, fq * 8);
#define PG8_SA(b, h) (((b) * 2 + (h)) * HTB)
#define PG8_SB(b, h) ((4 + (b) * 2 + (h)) * HTB)
#define PG8_STAGE(bufoff, gbase, voff) do { _Pragma("unroll") for (int _i = 0; _i < 2; ++_i) \
        __builtin_amdgcn_global_load_lds((const unsigned*)((const char*)(gbase) + (voff)[_i]), (PG8_LAS unsigned*)(lds + (bufoff) + ldsw + _i * 8192), 16, 0, 0); } while (0)
#define PG8_LDA(dst, b, h) do { _Pragma("unroll") for (int m = 0; m < 4; ++m) _Pragma("unroll") for (int k = 0; k < 2; ++k) dst[m][k] = *(const PG8_LAS bf16x8*)(lds + PG8_SA(b, h) + aoff + m * 2048 + k * 1024); } while (0)
#define PG8_LDB(dst, b, h) do { _Pragma("unroll") for (int n = 0; n < 2; ++n) _Pragma("unroll") for (int k = 0; k < 2; ++k) dst[n][k] = *(const PG8_LAS bf16x8*)(lds + PG8_SB(b, h) + boff + n * 2048 + k * 1024); } while (0)
#define PG8_MMA(ai, bj, At, Bt) do { __builtin_amdgcn_s_setprio(1); _Pragma("unroll") for (int m = 0; m < 4; ++m) _Pragma("unroll") for (int n = 0; n < 2; ++n) _Pragma("unroll") for (int k = 0; k < 2; ++k) \
        acc[ai][bj][m][n] = __builtin_amdgcn_mfma_f32_16x16x32_bf16(Bt[n][k], At[m][k], acc[ai][bj][m][n], 0, 0, 0); __builtin_amdgcn_s_setprio(0); } while (0)
#define PG8_WAIT_V(n) asm volatile("s_waitcnt vmcnt(" #n ")" ::: "memory")
#define PG8_WAIT_L(n) asm volatile("s_waitcnt lgkmcnt(" #n ")" ::: "memory")
#define PG8_BAR __builtin_amdgcn_s_barrier()
#define PG8_SCHED __builtin_amdgcn_sched_barrier(0)
    Unit cur, nxt; int ui = 0;
    if (!S.next(0, cur)) return;
    f32x4 acc[2][2][4][2];
#pragma unroll
    for (int a = 0; a < 2; ++a)
#pragma unroll
        for (int b = 0; b < 2; ++b)
#pragma unroll
            for (int m = 0; m < 4; ++m)
#pragma unroll
                for (int n = 0; n < 2; ++n) acc[a][b][m][n] = (f32x4){0.f, 0.f, 0.f, 0.f};
    bf16x8 At[4][2], B0[2][2], B1[2][2];
    const char* cA = (const char*)g.A + (size_t)cur.pm * tstep + S.a_off(cur); const char* cB = (const char*)g.Bt + (size_t)cur.pn * tstep;
    S.a_ready(cur);
    if constexpr (SP2) {
        PG8_STAGE(PG8_SB(0, 0), cB, voffB); PG8_STAGE(PG8_SB(0, 1), cB + hstep, voffB); PG8_STAGE(PG8_SA(0, 0), cA, voffA); PG8_STAGE(PG8_SA(0, 1), cA + hstep, voffA);
        if (wr == 1) PG8_BAR;
        PG8_WAIT_V(2); PG8_BAR;
        PG8_STAGE(PG8_SB(1, 0), cB + kstep, voffB); PG8_STAGE(PG8_SA(1, 0), cA + kstep, voffA); PG8_STAGE(PG8_SB(1, 1), cB + hstep + kstep, voffB);
        PG8_WAIT_V(6); PG8_BAR;
    } else {
        PG8_STAGE(PG8_SB(0, 0), cB, voffB); PG8_STAGE(PG8_SA(0, 0), cA, voffA); PG8_STAGE(PG8_SB(0, 1), cB + hstep, voffB); PG8_STAGE(PG8_SA(0, 1), cA + hstep, voffA);
        if (wr == 1) PG8_BAR;
        PG8_WAIT_V(4); PG8_BAR;
        PG8_STAGE(PG8_SB(1, 0), cB + kstep, voffB); PG8_STAGE(PG8_SA(1, 0), cA + kstep, voffA); PG8_STAGE(PG8_SB(1, 1), cB + hstep + kstep, voffB);
        PG8_WAIT_V(6); PG8_BAR;
    }
    for (;;) {
        const bool has_next = S.next(ui + 1, nxt);
        const char* nA = has_next ? (const char*)g.A + (size_t)nxt.pm * tstep + S.a_off(nxt) : cA; const char* nB = has_next ? (const char*)g.Bt + (size_t)nxt.pn * tstep : cB;
        for (int t = 0; t < nt; t += 2) {
            const bool last = (t == nt - 2);
            const char* a1 = cA + (size_t)(t + 1) * kstep;
            const char* a2 = last ? nA : cA + (size_t)(t + 2) * kstep; const char* b2 = last ? nB : cB + (size_t)(t + 2) * kstep;
            const char* a3 = a2 + kstep; const char* b3 = b2 + kstep;
            if (last && has_next) S.a_ready(nxt);
            if constexpr (SP2) {
            PG8_LDB(B0, 0, 0); PG8_LDB(B1, 0, 1); PG8_SCHED; PG8_LDA(At, 0, 0); PG8_STAGE(PG8_SA(1, 1), a1 + hstep, voffA);
            PG8_WAIT_V(8); PG8_WAIT_L(0); PG8_BAR; PG8_MMA(0, 0, At, B0); PG8_MMA(0, 1, At, B1); PG8_BAR; PG8_SCHED;
            PG8_LDA(At, 0, 1); PG8_STAGE(PG8_SB(0, 0), b2, voffB); PG8_STAGE(PG8_SB(0, 1), b2 + hstep, voffB); PG8_STAGE(PG8_SA(0, 0), a2, voffA);
            PG8_WAIT_V(8); PG8_WAIT_L(0); PG8_BAR; PG8_MMA(1, 0, At, B0); PG8_MMA(1, 1, At, B1); PG8_BAR; PG8_SCHED;
            PG8_LDB(B0, 1, 0); PG8_LDB(B1, 1, 1); PG8_SCHED; PG8_LDA(At, 1, 0); PG8_STAGE(PG8_SA(0, 1), a2 + hstep, voffA);
            PG8_WAIT_V(8); PG8_WAIT_L(0); PG8_BAR; PG8_MMA(0, 0, At, B0); PG8_MMA(0, 1, At, B1); PG8_BAR; PG8_SCHED;
            PG8_LDA(At, 1, 1); PG8_STAGE(PG8_SB(1, 0), b3, voffB); PG8_STAGE(PG8_SB(1, 1), b3 + hstep, voffB); PG8_STAGE(PG8_SA(1, 0), a3, voffA);
            PG8_WAIT_V(8); PG8_WAIT_L(0); PG8_BAR; PG8_MMA(1, 0, At, B0); PG8_MMA(1, 1, At, B1); PG8_BAR; PG8_SCHED;
            } else {
            PG8_LDB(B0, 0, 0); PG8_SCHED; PG8_LDA(At, 0, 0); PG8_STAGE(PG8_SA(1, 1), a1 + hstep, voffA);
            PG8_WAIT_L(8); PG8_BAR; PG8_WAIT_L(0); PG8_MMA(0, 0, At, B0); PG8_BAR; PG8_SCHED;
            PG8_LDB(B1, 0, 1); PG8_STAGE(PG8_SB(0, 0), b2, voffB);
            PG8_BAR; PG8_WAIT_L(0); PG8_MMA(0, 1, At, B1); PG8_BAR;
            PG8_LDA(At, 0, 1); PG8_STAGE(PG8_SA(0, 0), a2, voffA);
            PG8_BAR; PG8_WAIT_L(0); PG8_MMA(1, 0, At, B0); PG8_BAR; PG8_SCHED;
            PG8_STAGE(PG8_SB(0, 1), b2 + hstep, voffB);
            PG8_WAIT_V(6); PG8_BAR; PG8_MMA(1, 1, At, B1); PG8_BAR;
            PG8_LDB(B0, 1, 0); PG8_SCHED; PG8_LDA(At, 1, 0); PG8_STAGE(PG8_SA(0, 1), a2 + hstep, voffA);
            PG8_WAIT_L(8); PG8_BAR; PG8_WAIT_L(0); PG8_MMA(0, 0, At, B0); PG8_BAR; PG8_SCHED;
            PG8_LDB(B1, 1, 1); PG8_STAGE(PG8_SB(1, 0), b3, voffB);
            PG8_BAR; PG8_WAIT_L(0); PG8_MMA(0, 1, At, B1); PG8_BAR;
            PG8_LDA(At, 1, 1); PG8_STAGE(PG8_SA(1, 0), a3, voffA);
            PG8_BAR; PG8_WAIT_L(0); PG8_MMA(1, 0, At, B0); PG8_BAR; PG8_SCHED;
            PG8_STAGE(PG8_SB(1, 1), b3 + hstep, voffB);
            PG8_WAIT_V(6); PG8_BAR; PG8_MMA(1, 1, At, B1); PG8_BAR;
            }
        }
        if constexpr (ALIGN_EPI) { if (wr == 0) PG8_BAR; }
        if constexpr (!Epi::AFTER_DRAIN) { E(acc, cur, wr, wc, fr, fq); S.done(cur); }
        if (!has_next) break;
#pragma unroll
        for (int a = 0; a < 2; ++a)
#pragma unroll
            for (int b = 0; b < 2; ++b)
#pragma unroll
                for (int m = 0; m < 4; ++m)
#pragma unroll
                    for (int n = 0; n < 2; ++n) acc[a][b][m][n] = (f32x4){0.f, 0.f, 0.f, 0.f};
        cur = nxt; cA = nA; cB = nB; ++ui;
        if constexpr (ALIGN_EPI) { if (wr == 1) PG8_BAR; }
    }
    PG8_WAIT_V(0);
    if constexpr (!ALIGN_EPI) { if (wr == 0) PG8_BAR; }
    PG8_BAR;
    if constexpr (Epi::AFTER_DRAIN) { E.fused(acc, cur, wr, wc, fr, fq, lds, wid, lane); S.done(cur); }
#undef PG8_SA
#undef PG8_SB
#undef PG8_STAGE
#undef PG8_LDA
#undef PG8_LDB
#undef PG8_MMA
#undef PG8_WAIT_V
#undef PG8_WAIT_L
#undef PG8_BAR
#undef PG8_SCHED
}
}
#define GAS __attribute__((address_space(1)))
#define LAS __attribute__((address_space(3)))
typedef unsigned short bf16;
typedef unsigned v4u __attribute__((ext_vector_type(4)));
typedef float f32x4 __attribute__((ext_vector_type(4)));
typedef short bf16x8 __attribute__((ext_vector_type(8)));
typedef GAS unsigned gu32;
typedef GAS unsigned long long gu64;
#define RLX_AGENT __ATOMIC_RELAXED, __HIP_MEMORY_SCOPE_AGENT
#define LDS_WAIT() asm volatile("s_waitcnt lgkmcnt(0)" ::: "memory")
#define VM_WAIT() asm volatile("s_waitcnt vmcnt(0)" ::: "memory")
__device__ __forceinline__ unsigned long long rt() { return __builtin_amdgcn_s_memrealtime(); }
__device__ __forceinline__ unsigned f2bf(float f) { unsigned u = __builtin_bit_cast(unsigned, f); return (u + 0x7fffu + ((u >> 16) & 1u)) >> 16; }
__device__ __forceinline__ unsigned pk2(float lo, float hi) { return f2bf(lo) | (f2bf(hi) << 16); }
__device__ __forceinline__ float bf2f(bf16 v) { return __uint_as_float((unsigned)v << 16); }

#define XB_TMO      128
#define XB_XCNT(j)  (256  + 64 * (j))
#define XB_XSUB(j)  (1280 + 64 * (j))
#define XB_XGEN(j)  (2304 + 64 * (j))
#define XB_TOP      3328
#define XB_TOPGEN   3392
#define XCD_BAR_WORDS 3456
#define XB_SPIN_CAP (1u << 18)

__device__ __forceinline__ unsigned xb_ld(unsigned* p)              { return __hip_atomic_load(p, __ATOMIC_RELAXED, __HIP_MEMORY_SCOPE_AGENT); }
__device__ __forceinline__ unsigned xb_add(unsigned* p, unsigned v) { return __hip_atomic_fetch_add(p, v, __ATOMIC_RELAXED, __HIP_MEMORY_SCOPE_AGENT); }
__device__ __forceinline__ unsigned xb_xcc_id() { return (unsigned)__builtin_amdgcn_s_getreg((3 << 11) | 20) & 0xFu; }
#define XB_SPIN(cond, bar) do { unsigned _sp = 0; while (cond) { __builtin_amdgcn_s_sleep(1); \
    if ((++_sp & 255u) == 0u) { if (xb_ld(&(bar)[XB_TMO])) break; if (_sp > XB_SPIN_CAP) { atomicAdd(&(bar)[XB_TMO], 1u); break; } } } } while (0)

struct XcdBarrier {
    unsigned* bar; unsigned x;
    volatile LAS unsigned* st;
};

__device__ __forceinline__ XcdBarrier xcd_barrier_post(unsigned* bar, volatile LAS unsigned* st) {
    XcdBarrier b; b.bar = bar; b.x = xb_xcc_id(); b.st = st;
    if (threadIdx.x == 0) (void)xb_add(&bar[XB_XCNT(b.x)], 1u);
    return b;
}
__device__ __forceinline__ void xcd_barrier_complete(unsigned* bar, unsigned x, unsigned& nloc, unsigned& nx) {
    const unsigned G = gridDim.x * gridDim.y * gridDim.z;
    unsigned sum, cnt, mine, sp = 0u;
    for (;;) {
        sum = 0u; cnt = 0u; mine = 0u;
#pragma unroll
        for (unsigned j = 0; j < 16; ++j) { const unsigned c = xb_ld(&bar[XB_XCNT(j)]); sum += c; cnt += (c > 0u) ? 1u : 0u; mine = (j == x) ? c : mine; }
        if (sum == G) break;
        __builtin_amdgcn_s_sleep(1);
        if ((++sp & 255u) == 0u) { if (xb_ld(&bar[XB_TMO])) break; if (sp > XB_SPIN_CAP) { atomicAdd(&bar[XB_TMO], 1u); break; } }
    }
    nloc = mine > 0u ? mine : 1u; nx = cnt > 0u ? cnt : 1u;
}

__device__ __forceinline__ void xcd_barrier(const XcdBarrier& b) {
    asm volatile("s_waitcnt vmcnt(0)" ::: "memory");
    __syncthreads();
    if (threadIdx.x == 0) {
        unsigned* bar = b.bar;
        __builtin_amdgcn_s_waitcnt(0);
        unsigned nloc = b.st[0], nx = b.st[1];
        if (nloc == 0u) { xcd_barrier_complete(bar, b.x, nloc, nx); b.st[0] = nloc; b.st[1] = nx; }
        const unsigned old = xb_add(&bar[XB_XSUB(b.x)], 1u);
        const unsigned gen = old / nloc;
        if (old + 1u == (gen + 1u) * nloc) {
            __builtin_amdgcn_fence(__ATOMIC_RELEASE, "agent");
            asm volatile("s_waitcnt vmcnt(0)" ::: "memory");
            const unsigned og = xb_add(&bar[XB_TOP], 1u);
            const unsigned tg = og / nx;
            if (og + 1u == (tg + 1u) * nx) xb_add(&bar[XB_TOPGEN], 1u);
            else XB_SPIN(xb_ld(&bar[XB_TOPGEN]) == tg, bar);
            __builtin_amdgcn_fence(__ATOMIC_ACQUIRE, "agent");
            xb_add(&bar[XB_XGEN(b.x)], 1u);
            asm volatile("s_waitcnt vmcnt(0)" ::: "memory");
        } else {
            XB_SPIN(xb_ld(&bar[XB_XGEN(b.x)]) == gen, bar);
            __builtin_amdgcn_fence(__ATOMIC_ACQUIRE, "agent");
            asm volatile("s_waitcnt vmcnt(0)" ::: "memory");
        }
    }
    __syncthreads();
}
namespace da {
using bf16x8=__attribute__((ext_vector_type(8)))short;
using s16x4=__attribute__((ext_vector_type(4)))short;
using f32x16=__attribute__((ext_vector_type(16)))float;
using u32x4=__attribute__((ext_vector_type(4)))unsigned;
using f32x4=__attribute__((ext_vector_type(4)))float;
typedef unsigned short bf16_t;
#define DA_LAS __attribute__((address_space(3)))
constexpr int PQ=1536;
constexpr int KSLOT=16384, VSLOT=16384, SLOTB=KSLOT+VSLOT;
constexpr int OSTG=0;
constexpr int OROW=132;
__device__ __forceinline__ int crow(int r,int hi){return (r&3)+8*(r>>2)+4*hi;}
#define SBAR() __builtin_amdgcn_sched_barrier(0)
__device__ __forceinline__ void glds16(const void*gsrc,unsigned lds_dst){unsigned keep;
  asm volatile("s_mov_b32 %0, m0\n\ts_mov_b32 m0, %2\n\ts_nop 0\n\tglobal_load_lds_dwordx4 %1, off\n\ts_mov_b32 m0, %0":"=&s"(keep):"v"(gsrc),"s"(lds_dst):"memory");}
typedef float f32x2_t __attribute__((ext_vector_type(2))); typedef __bf16 bf16x2_t __attribute__((ext_vector_type(2)));
__device__ __forceinline__ unsigned cvtpk_s(float lo,float hi){f32x2_t v={lo,hi};bf16x2_t b=__builtin_convertvector(v,bf16x2_t);return __builtin_bit_cast(unsigned,b);}
__device__ __forceinline__ void qkt(f32x16&p0,f32x16&p1,const DA_LAS char*kb,const bf16x8*qr,const f32x16&negm){
  #pragma unroll
  for(int d0=0;d0<4;++d0){
    const bf16x8 b0=*(const DA_LAS bf16x8*)(kb+d0*2048);
    const bf16x8 b1=*(const DA_LAS bf16x8*)(kb+d0*2048+512);
    if(d0==0){p0=__builtin_amdgcn_mfma_f32_32x32x16_bf16(b0,qr[0],negm,0,0,0);p1=__builtin_amdgcn_mfma_f32_32x32x16_bf16(b1,qr[0],negm,0,0,0);}
    else{p0=__builtin_amdgcn_mfma_f32_32x32x16_bf16(b0,qr[d0],p0,0,0,0);p1=__builtin_amdgcn_mfma_f32_32x32x16_bf16(b1,qr[d0],p1,0,0,0);}}
}
__device__ __forceinline__ void pv(f32x16*o,int vb,bf16x8 pa0,bf16x8 pa1,bf16x8 pa2,bf16x8 pa3){
  #pragma unroll
  for(int eb=0;eb<4;++eb){s16x4 lo[4],hi[4];
    #pragma unroll
    for(int ks=0;ks<4;++ks){
      asm volatile("ds_read_b64_tr_b16 %0,%1 offset:%c2":"=&v"(lo[ks]):"v"(vb),"i"(eb*4096+ks*1024):"memory");
      asm volatile("ds_read_b64_tr_b16 %0,%1 offset:%c2":"=&v"(hi[ks]):"v"(vb),"i"(eb*4096+ks*1024+512):"memory");}
    asm volatile("s_waitcnt lgkmcnt(0)":::"memory");SBAR();
    #define PK(k) (bf16x8){lo[k][0],lo[k][1],lo[k][2],lo[k][3],hi[k][0],hi[k][1],hi[k][2],hi[k][3]}
    o[eb]=__builtin_amdgcn_mfma_f32_32x32x16_bf16(pa0,PK(0),o[eb],0,0,0);
    o[eb]=__builtin_amdgcn_mfma_f32_32x32x16_bf16(pa1,PK(1),o[eb],0,0,0);
    o[eb]=__builtin_amdgcn_mfma_f32_32x32x16_bf16(pa2,PK(2),o[eb],0,0,0);
    o[eb]=__builtin_amdgcn_mfma_f32_32x32x16_bf16(pa3,PK(3),o[eb],0,0,0);
    #undef PK
  }
}
struct Tensors { const bf16_t* qkv; const bf16_t* za; bf16_t* ya; const float* og; float lam; float negM; };
__device__ __forceinline__ void attn_unit(int b,int h,int j,const Tensors&T,DA_LAS char*shm){
  const int tid=threadIdx.x,lane=tid&63,r32=lane&31,hi=lane>>5; const int wid=__builtin_amdgcn_readfirstlane(tid>>6);
  const int qsub=wid&3,mp=wid>>2;
  const long rowbase=(long)b*8192; const int q0=j*128;
  const bf16_t*Qw=T.qkv+(rowbase+q0+qsub*32)*PQ+h*128+mp*64;
  const bf16_t*Kh=T.qkv+rowbase*PQ+512+h*128,*Vh=T.qkv+rowbase*PQ+1024+h*128;
  const unsigned lds0=(unsigned)(uintptr_t)shm;
  const int NT=2*j+2, NTw=2*j+1+(qsub>>1);
  const bf16_t*ksrc0=Kh+(long)lane*PQ+wid*8, *ksrc1=ksrc0+64;
  const bf16_t*vsrc0=Vh+(long)(16*(wid&3)+(lane>>2))*PQ+(wid>>2)*32+(lane&3)*8, *vsrc1=vsrc0+64;
  #define DMA_TILE(t,slot) do{ const long ro_=(long)(t)*64*PQ; const unsigned sb_=lds0+(slot)*SLOTB; \
     glds16(ksrc0+ro_,(unsigned)__builtin_amdgcn_readfirstlane(sb_+wid*1024)); glds16(ksrc1+ro_,(unsigned)__builtin_amdgcn_readfirstlane(sb_+(wid+8)*1024)); \
     glds16(vsrc0+ro_,(unsigned)__builtin_amdgcn_readfirstlane(sb_+KSLOT+wid*1024)); glds16(vsrc1+ro_,(unsigned)__builtin_amdgcn_readfirstlane(sb_+KSLOT+(wid+8)*1024)); }while(0)
  DMA_TILE(0,0);
  bf16x8 qr[4];
  #pragma unroll
  for(int d0=0;d0<4;++d0)qr[d0]=*reinterpret_cast<const bf16x8*>(&Qw[(long)r32*PQ+d0*16+hi*8]);
  float l_reg=0.f; f32x16 o[4]; o[0]=f32x16{};o[1]=f32x16{};o[2]=f32x16{};o[3]=f32x16{};
  f32x16 negm;
  #pragma unroll
  for(int r=0;r<16;++r)negm[r]=T.negM;
  const int vb0=(int)lds0+KSLOT+((lane>>4)&1)*32+(lane&3)*8+(4*hi+((lane&15)>>2))*64;
  const DA_LAS char*kp0=shm+mp*8192+hi*1024+r32*16;
  for(int t=0;t<NT;++t){
    const int sl=t&1;
    if(t+1<NT){ DMA_TILE(t+1,sl^1); asm volatile("s_waitcnt vmcnt(4) lgkmcnt(0)\n\ts_barrier":::"memory"); }
    else { asm volatile("s_waitcnt vmcnt(0) lgkmcnt(0)\n\ts_barrier":::"memory"); }
    if(t<NTw){
      f32x16 p0,p1;
      qkt(p0,p1,kp0+sl*SLOTB,qr,negm);
      #pragma unroll
      for(int r=0;r<16;++r){p0[r]=__builtin_amdgcn_exp2f(p0[r]);p1[r]=__builtin_amdgcn_exp2f(p1[r]);}
      float sacc=0.f;
      #pragma unroll
      for(int r=0;r<16;++r)sacc+=p0[r]+p1[r];
      l_reg+=sacc;
      u32x4 pw0,pw1,pw2,pw3;
      #define PKW(P,B) cvtpk_s(P[B],P[B+1])
      pw0=(u32x4){PKW(p0,0),PKW(p0,2),PKW(p0,4),PKW(p0,6)};pw1=(u32x4){PKW(p0,8),PKW(p0,10),PKW(p0,12),PKW(p0,14)};
      pw2=(u32x4){PKW(p1,0),PKW(p1,2),PKW(p1,4),PKW(p1,6)};pw3=(u32x4){PKW(p1,8),PKW(p1,10),PKW(p1,12),PKW(p1,14)};
      #undef PKW
      SBAR();
      pv(o,vb0+sl*SLOTB,__builtin_bit_cast(bf16x8,pw0),__builtin_bit_cast(bf16x8,pw1),__builtin_bit_cast(bf16x8,pw2),__builtin_bit_cast(bf16x8,pw3));
    }
    asm volatile("s_waitcnt lgkmcnt(0)\n\ts_barrier":::"memory");
  }
  #undef DMA_TILE
  {auto rr=__builtin_amdgcn_permlane32_swap(__float_as_uint(l_reg),__float_as_uint(l_reg),false,false);l_reg=__uint_as_float(rr[0])+__uint_as_float(rr[1]);}
  DA_LAS float*lsc=(DA_LAS float*)(shm+OSTG+4*32*OROW*4)+wid*32;
  DA_LAS float*stg=(DA_LAS float*)(shm+OSTG)+qsub*32*OROW;
  if(hi==0)lsc[r32]=l_reg; asm volatile("s_waitcnt lgkmcnt(0)":::"memory");
  float rli[16];
  #pragma unroll
  for(int r=0;r<16;++r)rli[r]=__builtin_amdgcn_rcpf(lsc[crow(r,hi)]);
  if(mp==1){
    #pragma unroll
    for(int r=0;r<16;++r){const int orow=crow(r,hi); const float f=rli[r]*T.lam;
      #pragma unroll
      for(int eb=0;eb<4;++eb)stg[orow*OROW+eb*32+r32]=o[eb][r]*f;}
  }
  asm volatile("s_waitcnt lgkmcnt(0)\n\ts_barrier":::"memory");
  if(mp==0){
    #pragma unroll
    for(int r=0;r<16;++r){const int orow=crow(r,hi);
      #pragma unroll
      for(int eb=0;eb<4;++eb){const float d=o[eb][r]*rli[r]-stg[orow*OROW+eb*32+r32]; o[eb][r]=d;}}
    asm volatile("s_waitcnt lgkmcnt(0)":::"memory");
    #pragma unroll
    for(int r=0;r<16;++r){const int orow=crow(r,hi);
      #pragma unroll
      for(int eb=0;eb<4;++eb)stg[orow*OROW+eb*32+r32]=o[eb][r];}
    asm volatile("s_waitcnt lgkmcnt(0)":::"memory");
    const int row=lane>>1,hf=lane&1; const DA_LAS float*rp=stg+row*OROW+hf*64;
    const long grow=rowbase+q0+qsub*32+row;
    const bf16_t*zp=T.za+grow*512+h*128+hf*64; bf16_t*yp=T.ya+grow*512+h*128+hf*64; const float*gp=T.og+hf*64;
    float ss=0.f;
    #pragma unroll
    for(int i=0;i<16;++i){const f32x4 v=*(const DA_LAS f32x4*)(rp+4*i); ss+=(v[0]*v[0]+v[1]*v[1])+(v[2]*v[2]+v[3]*v[3]);}
    ss+=__shfl_xor(ss,1);
    const float rs=__builtin_amdgcn_rsqf(ss*(1.0f/128.0f)+1e-6f)*0.8f;
    #pragma unroll
    for(int i=0;i<8;++i){const f32x4 v0=*(const DA_LAS f32x4*)(rp+8*i),v1=*(const DA_LAS f32x4*)(rp+8*i+4); const f32x4 g0=*(const f32x4*)(gp+8*i),g1=*(const f32x4*)(gp+8*i+4);
      const u32x4 z=*(const u32x4*)(zp+8*i);
      u32x4 w; w.x=cvtpk_s(v0[0]*rs*g0[0]*pg8::bf_lo(z.x),v0[1]*rs*g0[1]*pg8::bf_hi(z.x)); w.y=cvtpk_s(v0[2]*rs*g0[2]*pg8::bf_lo(z.y),v0[3]*rs*g0[3]*pg8::bf_hi(z.y));
      w.z=cvtpk_s(v1[0]*rs*g1[0]*pg8::bf_lo(z.z),v1[1]*rs*g1[1]*pg8::bf_hi(z.z)); w.w=cvtpk_s(v1[2]*rs*g1[2]*pg8::bf_lo(z.w),v1[3]*rs*g1[3]*pg8::bf_hi(z.w));
      *(u32x4*)(yp+8*i)=w;}
  }
  asm volatile("s_waitcnt lgkmcnt(0)\n\ts_barrier":::"memory");
}
#undef SBAR
}
namespace gdn {
typedef short bf16x8 __attribute__((ext_vector_type(8)));
typedef short s16x4 __attribute__((ext_vector_type(4)));
typedef float f32x4 __attribute__((ext_vector_type(4)));
typedef unsigned u32x2 __attribute__((ext_vector_type(2)));
typedef unsigned u32x4 __attribute__((ext_vector_type(4)));
typedef unsigned short bf16_t;
#define GD_LAS __attribute__((address_space(3)))
constexpr int REC_BYTES = 57344, REC_W = 0, REC_QD = 16384, REC_KTT = 32768, REC_A = 49152;
constexpr int R1 = 0, R2 = 33792, KNB = 67584, QNB = 84992, KBGT = 102400, VBT = 120832, YT = 139264, MISC = 142528;
constexpr int TS = 68;
__device__ __forceinline__ unsigned pk(float lo, float hi) { return da::cvtpk_s(lo, hi); }
__device__ __forceinline__ float bflo(unsigned w) { return __uint_as_float(w << 16); }
__device__ __forceinline__ float bfhi(unsigned w) { return __uint_as_float(w & 0xffff0000u); }
__device__ __forceinline__ float silu(float y) { return y * __builtin_amdgcn_rcpf(1.0f + __builtin_amdgcn_exp2f(-1.4426950408889634f * y)); }

struct PrepT { const bf16_t* qkvb; const float* gb; const float* conv_w; unsigned char* rec; bf16_t* ut; float* gl; };

__device__ __forceinline__ void prep_unit(int bh, int n, const PrepT& P, GD_LAS unsigned char* lds) {
    const int tid = threadIdx.x, lane = tid & 63; const int wv = __builtin_amdgcn_readfirstlane(tid >> 6);
    const int b = bh >> 2, h = bh & 3; const size_t row0 = (size_t)b * 8192 + (size_t)n * 64;
    GD_LAS float* qs = (GD_LAS float*)(lds + R1); GD_LAS float* ks = (GD_LAS float*)(lds + R2);
    GD_LAS float* Gs = (GD_LAS float*)(lds + MISC); GD_LAS float* Bs = Gs + 64;
    unsigned char* rec = P.rec + (size_t)(bh * 128 + n) * REC_BYTES;
    if (wv == 6) { float g = P.gb[(row0 + lane) * 8 + h]; const float be = P.gb[(row0 + lane) * 8 + 4 + h];
#pragma unroll
        for (int o = 1; o < 64; o <<= 1) { const float v = __shfl_up(g, o); if (lane >= o) g += v; }
        Gs[lane] = g; Bs[lane] = be; if (lane == 63) P.gl[bh * 128 + n] = __expf(g); }
    if (tid < 384) {
        const int kind = tid >> 7, cq = tid & 31, tg = (tid >> 5) & 3; const int col = kind * 512 + h * 128 + 4 * cq;
        f32x4 w[4];
#pragma unroll
        for (int j = 0; j < 4; ++j) w[j] = *(const f32x4*)(P.conv_w + j * 1536 + col);
        const bf16_t* p = P.qkvb + (row0 + 16 * tg) * 1536 + col;
        f32x4 x0 = {0.f, 0.f, 0.f, 0.f}, x1 = x0, x2 = x0;
        if (n > 0 || tg > 0) { const u32x2 a0 = *(const u32x2*)(p - 3 * 1536), a1 = *(const u32x2*)(p - 2 * 1536), a2 = *(const u32x2*)(p - 1536);
            x0 = (f32x4){bflo(a0.x), bfhi(a0.x), bflo(a0.y), bfhi(a0.y)}; x1 = (f32x4){bflo(a1.x), bfhi(a1.x), bflo(a1.y), bfhi(a1.y)}; x2 = (f32x4){bflo(a2.x), bfhi(a2.x), bflo(a2.y), bfhi(a2.y)}; }
#pragma unroll 4
        for (int t = 0; t < 16; ++t) { const u32x2 a3 = *(const u32x2*)(p + (size_t)t * 1536); const f32x4 x3 = {bflo(a3.x), bfhi(a3.x), bflo(a3.y), bfhi(a3.y)};
            f32x4 y = w[0] * x0 + w[1] * x1 + w[2] * x2 + w[3] * x3;
#pragma unroll
            for (int e = 0; e < 4; ++e) y[e] = silu(y[e]);
            const int tt = 16 * tg + t;
            if (kind == 0) *(GD_LAS f32x4*)(qs + tt * 132 + 4 * cq) = y;
            else if (kind == 1) *(GD_LAS f32x4*)(ks + tt * 132 + 4 * cq) = y;
            else { const float be = P.gb[(row0 + tt) * 8 + 4 + h]; GD_LAS bf16_t* vb = (GD_LAS bf16_t*)(lds + VBT);
#pragma unroll
                for (int e = 0; e < 4; ++e) vb[(4 * cq + e) * 72 + tt] = (bf16_t)(pk(y[e] * be, 0.f) & 0xffffu); }
            x0 = x1; x1 = x2; x2 = x3; }
    }
    __syncthreads();
    const int t8 = tid >> 3, sg = tid & 7;
    const float Gt = Gs[t8], Bt = Bs[t8], Gl = Gs[63];
    { const GD_LAS float* rp = qs + t8 * 132 + 16 * sg; f32x4 v[4]; float ss = 0.f;
#pragma unroll
      for (int i = 0; i < 4; ++i) { v[i] = *(const GD_LAS f32x4*)(rp + 4 * i); ss += (v[i][0] * v[i][0] + v[i][1] * v[i][1]) + (v[i][2] * v[i][2] + v[i][3] * v[i][3]); }
      ss += __shfl_xor(ss, 1); ss += __shfl_xor(ss, 2); ss += __shfl_xor(ss, 4);
      const float rs = (1.0f / sqrtf(ss + 1e-6f)) * 0.08838834764831845f; const float eg = __expf(Gt);
      unsigned wq[8];
#pragma unroll
      for (int i = 0; i < 4; ++i) { v[i] = v[i] * rs; wq[2 * i] = pk(v[i][0], v[i][1]); wq[2 * i + 1] = pk(v[i][2], v[i][3]); }
      GD_LAS u32x4* dq = (GD_LAS u32x4*)(lds + QNB + t8 * 272 + sg * 32); dq[0] = (u32x4){wq[0], wq[1], wq[2], wq[3]}; dq[1] = (u32x4){wq[4], wq[5], wq[6], wq[7]};
#pragma unroll
      for (int i = 0; i < 4; ++i) { const int c = 4 * sg + i; const f32x4 d = v[i] * eg; *(u32x2*)(rec + REC_QD + t8 * 256 + ((c ^ (2 * (t8 & 15))) * 8)) = (u32x2){pk(d[0], d[1]), pk(d[2], d[3])}; } }
    __syncthreads();
    { const GD_LAS float* rp = ks + t8 * 132 + 16 * sg; f32x4 v[4]; float ss = 0.f;
#pragma unroll
      for (int i = 0; i < 4; ++i) { v[i] = *(const GD_LAS f32x4*)(rp + 4 * i); ss += (v[i][0] * v[i][0] + v[i][1] * v[i][1]) + (v[i][2] * v[i][2] + v[i][3] * v[i][3]); }
      ss += __shfl_xor(ss, 1); ss += __shfl_xor(ss, 2); ss += __shfl_xor(ss, 4);
      const float rs = 1.0f / sqrtf(ss + 1e-6f); const float f1 = Bt * __expf(Gt), f2 = __expf(Gl - Gt);
      unsigned wq[8];
#pragma unroll
      for (int i = 0; i < 4; ++i) { v[i] = v[i] * rs; wq[2 * i] = pk(v[i][0], v[i][1]); wq[2 * i + 1] = pk(v[i][2], v[i][3]); }
      GD_LAS u32x4* dk_ = (GD_LAS u32x4*)(lds + KNB + t8 * 272 + sg * 32); dk_[0] = (u32x4){wq[0], wq[1], wq[2], wq[3]}; dk_[1] = (u32x4){wq[4], wq[5], wq[6], wq[7]};
      GD_LAS bf16_t* kb = (GD_LAS bf16_t*)(lds + KBGT); GD_LAS unsigned char* kt = lds + R1;
#pragma unroll
      for (int i = 0; i < 4; ++i)
#pragma unroll
          for (int e = 0; e < 4; ++e) { const int d = 16 * sg + 4 * i + e; const float kv = v[i][e];
              kb[d * 72 + t8] = (bf16_t)(pk(kv * f1, 0.f) & 0xffffu);
              *(GD_LAS bf16_t*)(kt + d * 128 + (((t8 >> 2) ^ (2 * ((d >> 1) & 7))) * 8) + (t8 & 3) * 2) = (bf16_t)(pk(kv * f2, 0.f) & 0xffffu); } }
    __syncthreads();
#pragma unroll
    for (int r = 0; r < 2; ++r) { const int o = (r * 512 + tid) * 16; *(u32x4*)(rec + REC_KTT + o) = *(const GD_LAS u32x4*)(lds + R1 + o); }
    GD_LAS float* Am = (GD_LAS float*)(lds + R2);
    const int c16 = lane & 15, kg = lane >> 4;
    for (int tl = wv; tl < 26; tl += 8) {
        if (tl < 10) {
            int it = 0, rem = tl; while (rem > it) { rem -= it + 1; ++it; } const int jt = rem;
            f32x4 acc = {0.f, 0.f, 0.f, 0.f};
#pragma unroll
            for (int s = 0; s < 4; ++s) { const bf16x8 a = *(const GD_LAS bf16x8*)(lds + KNB + (16 * it + c16) * 272 + (32 * s + 8 * kg) * 2), bb = *(const GD_LAS bf16x8*)(lds + KNB + (16 * jt + c16) * 272 + (32 * s + 8 * kg) * 2);
                acc = __builtin_amdgcn_mfma_f32_16x16x32_bf16(a, bb, acc, 0, 0, 0); }
            const int j = 16 * jt + c16; const float Gj = Gs[j];
#pragma unroll
            for (int r = 0; r < 4; ++r) { const int i = 16 * it + 4 * kg + r; Am[i * TS + j] = (i > j) ? Bs[i] * acc[r] * __expf(Gs[i] - Gj) : 0.f; }
        } else {
            const int q = tl - 10, it = q >> 2, jt = q & 3;
            f32x4 acc = {0.f, 0.f, 0.f, 0.f};
            if (it >= jt) {
#pragma unroll
                for (int s = 0; s < 4; ++s) { const bf16x8 a = *(const GD_LAS bf16x8*)(lds + KNB + (16 * jt + c16) * 272 + (32 * s + 8 * kg) * 2), bb = *(const GD_LAS bf16x8*)(lds + QNB + (16 * it + c16) * 272 + (32 * s + 8 * kg) * 2);
                    acc = __builtin_amdgcn_mfma_f32_16x16x32_bf16(a, bb, acc, 0, 0, 0); } }
            const int i = 16 * it + c16; const float Gi = Gs[i]; float vv[4];
#pragma unroll
            for (int r = 0; r < 4; ++r) { const int j = 16 * jt + 4 * kg + r; vv[r] = (i >= j) ? acc[r] * __expf(Gi - Gs[j]) : 0.f; }
            const int c = 4 * jt + kg;
            *(u32x2*)(rec + REC_A + i * 128 + ((c ^ (2 * ((i >> 1) & 7))) * 8)) = (u32x2){pk(vv[0], vv[1]), pk(vv[2], vv[3])};
        }
    }
    __syncthreads();
    GD_LAS float* Tm = (GD_LAS float*)(lds + R1); GD_LAS float* Yt = (GD_LAS float*)(lds + YT);
    if (wv == 0) { const int blk = lane >> 4, c = lane & 15; float x[16];
#pragma unroll
        for (int i = 0; i < 16; ++i) { float s = (i == c) ? 1.f : 0.f;
#pragma unroll
            for (int j = 0; j < i; ++j) s -= Am[(16 * blk + i) * TS + 16 * blk + j] * x[j];
            x[i] = s; }
#pragma unroll
        for (int i = 0; i < 16; ++i) Tm[(16 * blk + i) * TS + 16 * blk + c] = x[i];
    } else { for (int e = tid - 64; e < 6 * 256; e += 448) { const int bq = e >> 8, i = (e >> 4) & 15, c = e & 15; const int I = (bq < 3) ? 0 : (bq < 5 ? 1 : 2), J = (bq < 3) ? bq + 1 : (bq < 5 ? bq - 1 : 3);
            Tm[(16 * I + i) * TS + 16 * J + c] = 0.f; } }
    __syncthreads();
    for (int d = 1; d < 4; ++d) {
        const int nb = 4 - d;
        for (int e = tid; e < nb * 256; e += 512) { const int bq = e >> 8, i = (e >> 4) & 15, c = e & 15; const int I = bq + d, J = bq; float y = 0.f;
            for (int K = J; K < I; ++K)
#pragma unroll
                for (int k = 0; k < 16; ++k) y += Am[(16 * I + i) * TS + 16 * K + k] * Tm[(16 * K + k) * TS + 16 * J + c];
            Yt[(bq * 16 + i) * 17 + c] = y; }
        __syncthreads();
        for (int e = tid; e < nb * 256; e += 512) { const int bq = e >> 8, i = (e >> 4) & 15, c = e & 15; const int I = bq + d, J = bq; float x = 0.f;
#pragma unroll
            for (int k = 0; k < 16; ++k) x -= Tm[(16 * I + i) * TS + 16 * I + k] * Yt[(bq * 16 + k) * 17 + c];
            Tm[(16 * I + i) * TS + 16 * J + c] = x; }
        __syncthreads();
    }
    bf16_t* ut = P.ut + (size_t)(bh * 128 + n) * 8192;
    for (int tl = wv; tl < 64; tl += 8) {
        f32x4 acc = {0.f, 0.f, 0.f, 0.f};
        if (tl < 32) { const int mt = tl >> 3, nt = tl & 7;
#pragma unroll
            for (int s = 0; s < 2; ++s) { const GD_LAS float* tp = Tm + (16 * mt + c16) * TS + 32 * s + 8 * kg; const f32x4 t0 = *(const GD_LAS f32x4*)tp, t1 = *(const GD_LAS f32x4*)(tp + 4);
                const u32x4 aw = {pk(t0[0], t0[1]), pk(t0[2], t0[3]), pk(t1[0], t1[1]), pk(t1[2], t1[3])};
                const bf16x8 bb = *(const GD_LAS bf16x8*)(lds + VBT + (16 * nt + c16) * 144 + (32 * s + 8 * kg) * 2);
                acc = __builtin_amdgcn_mfma_f32_16x16x32_bf16(__builtin_bit_cast(bf16x8, aw), bb, acc, 0, 0, 0); }
            *(u32x2*)(ut + (16 * nt + c16) * 64 + 16 * mt + 4 * kg) = (u32x2){pk(acc[0], acc[1]), pk(acc[2], acc[3])};
        } else { const int q = tl - 32, dt = q >> 2, it = q & 3;
#pragma unroll
            for (int s = 0; s < 2; ++s) { const bf16x8 a = *(const GD_LAS bf16x8*)(lds + KBGT + (16 * dt + c16) * 144 + (32 * s + 8 * kg) * 2);
                const GD_LAS float* tp = Tm + (16 * it + c16) * TS + 32 * s + 8 * kg; const f32x4 t0 = *(const GD_LAS f32x4*)tp, t1 = *(const GD_LAS f32x4*)(tp + 4);
                const u32x4 bw = {pk(t0[0], t0[1]), pk(t0[2], t0[3]), pk(t1[0], t1[1]), pk(t1[2], t1[3])};
                acc = __builtin_amdgcn_mfma_f32_16x16x32_bf16(a, __builtin_bit_cast(bf16x8, bw), acc, 0, 0, 0); }
            const int i = 16 * it + c16, c = 4 * dt + kg;
            *(u32x2*)(rec + REC_W + i * 256 + ((c ^ (2 * (i & 15))) * 8)) = (u32x2){pk(acc[0], acc[1]), pk(acc[2], acc[3])};
        }
    }
    __syncthreads();
}

constexpr int SC_SLOT = REC_BYTES, SC_OS = 2 * REC_BYTES;
struct ScanT { const unsigned char* rec; const bf16_t* ut; const float* gl; const bf16_t* zb; bf16_t* yb; const float* gnw; };
__device__ __forceinline__ bf16x8 frag(const GD_LAS unsigned char* rowp, int c, int sw) {
    const s16x4 lo = *(const GD_LAS s16x4*)(rowp + ((c ^ sw) * 8)), hi = *(const GD_LAS s16x4*)(rowp + (((c + 4) ^ sw) * 8));
    return (bf16x8){lo[0], lo[1], lo[2], lo[3], hi[0], hi[1], hi[2], hi[3]};
}
__device__ __forceinline__ void scan_bh(int bh, const ScanT& P, GD_LAS unsigned char* lds) {
    const int tid = threadIdx.x, lane = tid & 63; const int wv = __builtin_amdgcn_readfirstlane(tid >> 6);
    const int c16 = lane & 15, kg = lane >> 4; const int b = bh >> 2, h = bh & 3;
    const unsigned lds0 = (unsigned)(uintptr_t)lds;
    const unsigned char* recb = P.rec + (size_t)bh * 128 * REC_BYTES;
    const bf16_t* utb = P.ut + (size_t)bh * 128 * 8192 + (16 * wv + c16) * 64 + 4 * kg;
    GD_LAS float* os = (GD_LAS float*)(lds + SC_OS);
    f32x4 S[8];
#pragma unroll
    for (int i = 0; i < 8; ++i) S[i] = (f32x4){0.f, 0.f, 0.f, 0.f};
#define SC_DMA(nn, slot) do { const unsigned char* src_ = recb + (size_t)(nn) * REC_BYTES + lane * 16; const unsigned dst_ = lds0 + (slot) * SC_SLOT; \
        _Pragma("unroll") for (int r_ = 0; r_ < 7; ++r_) da::glds16(src_ + (r_ * 8 + wv) * 1024, (unsigned)__builtin_amdgcn_readfirstlane(dst_ + (r_ * 8 + wv) * 1024)); } while (0)
    SC_DMA(0, 0);
    u32x2 ucur[4], unxt[4];
#pragma unroll
    for (int mt = 0; mt < 4; ++mt) ucur[mt] = *(const u32x2*)(utb + 16 * mt);
    const int sw256 = 2 * c16, sw128 = 2 * (c16 >> 1);
    const size_t rowb = (size_t)b * 8192;
    for (int n = 0; n < 128; ++n) {
        const int sl = n & 1;
        asm volatile("s_waitcnt vmcnt(0) lgkmcnt(0)\n\ts_barrier" ::: "memory");
        if (n + 1 < 128) { SC_DMA(n + 1, sl ^ 1);
#pragma unroll
            for (int mt = 0; mt < 4; ++mt) unxt[mt] = *(const u32x2*)(utb + (size_t)(n + 1) * 8192 + 16 * mt); }
        const float gl = P.gl[bh * 128 + n];
        const GD_LAS unsigned char* base = lds + sl * SC_SLOT;
        bf16x8 Sb[4];
#pragma unroll
        for (int s = 0; s < 4; ++s) { const u32x4 w4 = {pk(S[2 * s][0], S[2 * s][1]), pk(S[2 * s][2], S[2 * s][3]), pk(S[2 * s + 1][0], S[2 * s + 1][1]), pk(S[2 * s + 1][2], S[2 * s + 1][3])}; Sb[s] = __builtin_bit_cast(bf16x8, w4); }
        f32x4 vn[4];
#pragma unroll
        for (int mt = 0; mt < 4; ++mt) { f32x4 acc = {0.f, 0.f, 0.f, 0.f}; const GD_LAS unsigned char* rp = base + REC_W + (16 * mt + c16) * 256;
#pragma unroll
            for (int s = 0; s < 4; ++s) acc = __builtin_amdgcn_mfma_f32_16x16x32_bf16(frag(rp, 8 * s + kg, sw256), Sb[s], acc, 0, 0, 0);
            const u32x2 uu = ucur[mt]; vn[mt] = (f32x4){bflo(uu.x), bfhi(uu.x), bflo(uu.y), bfhi(uu.y)} - acc; }
        bf16x8 vb[2];
#pragma unroll
        for (int s = 0; s < 2; ++s) { const u32x4 w4 = {pk(vn[2 * s][0], vn[2 * s][1]), pk(vn[2 * s][2], vn[2 * s][3]), pk(vn[2 * s + 1][0], vn[2 * s + 1][1]), pk(vn[2 * s + 1][2], vn[2 * s + 1][3])}; vb[s] = __builtin_bit_cast(bf16x8, w4); }
#pragma unroll
        for (int mt = 0; mt < 4; ++mt) { f32x4 acc = {0.f, 0.f, 0.f, 0.f}; const GD_LAS unsigned char* rp = base + REC_QD + (16 * mt + c16) * 256; const GD_LAS unsigned char* ap = base + REC_A + (16 * mt + c16) * 128;
#pragma unroll
            for (int s = 0; s < 4; ++s) acc = __builtin_amdgcn_mfma_f32_16x16x32_bf16(frag(rp, 8 * s + kg, sw256), Sb[s], acc, 0, 0, 0);
#pragma unroll
            for (int s = 0; s < 2; ++s) acc = __builtin_amdgcn_mfma_f32_16x16x32_bf16(frag(ap, 8 * s + kg, sw128), vb[s], acc, 0, 0, 0);
#pragma unroll
            for (int r = 0; r < 4; ++r) os[(16 * mt + 4 * kg + r) * 132 + 16 * wv + c16] = acc[r]; }
#pragma unroll
        for (int dt = 0; dt < 8; ++dt) { f32x4 acc = S[dt] * gl; const GD_LAS unsigned char* kp = base + REC_KTT + (16 * dt + c16) * 128;
#pragma unroll
            for (int s = 0; s < 2; ++s) acc = __builtin_amdgcn_mfma_f32_16x16x32_bf16(frag(kp, 8 * s + kg, sw128), vb[s], acc, 0, 0, 0);
            S[dt] = acc; }
        asm volatile("s_waitcnt lgkmcnt(0)\n\ts_barrier" ::: "memory");
        { const int t = tid >> 3, sg = tid & 7; const GD_LAS float* op = os + t * 132 + sg * 16; f32x4 v[4]; float ss = 0.f;
#pragma unroll
          for (int i = 0; i < 4; ++i) { v[i] = *(const GD_LAS f32x4*)(op + 4 * i); ss += (v[i][0] * v[i][0] + v[i][1] * v[i][1]) + (v[i][2] * v[i][2] + v[i][3] * v[i][3]); }
          ss += __shfl_xor(ss, 1); ss += __shfl_xor(ss, 2); ss += __shfl_xor(ss, 4);
          const float rs = 1.0f / sqrtf(ss * (1.0f / 128.0f) + 1e-6f);
          const size_t row = rowb + (size_t)n * 64 + t; const bf16_t* zp = P.zb + row * 512 + h * 128 + sg * 16; bf16_t* yp = P.yb + row * 512 + h * 128 + sg * 16;
          const u32x4 z0 = *(const u32x4*)zp, z1 = *(const u32x4*)(zp + 8); const float* gw = P.gnw + sg * 16;
          const f32x4 g0 = *(const f32x4*)gw, g1 = *(const f32x4*)(gw + 4), g2 = *(const f32x4*)(gw + 8), g3 = *(const f32x4*)(gw + 12);
          u32x4 o0, o1;
          o0.x = pk(v[0][0] * rs * g0[0] * bflo(z0.x), v[0][1] * rs * g0[1] * bfhi(z0.x)); o0.y = pk(v[0][2] * rs * g0[2] * bflo(z0.y), v[0][3] * rs * g0[3] * bfhi(z0.y));
          o0.z = pk(v[1][0] * rs * g1[0] * bflo(z0.z), v[1][1] * rs * g1[1] * bfhi(z0.z)); o0.w = pk(v[1][2] * rs * g1[2] * bflo(z0.w), v[1][3] * rs * g1[3] * bfhi(z0.w));
          o1.x = pk(v[2][0] * rs * g2[0] * bflo(z1.x), v[2][1] * rs * g2[1] * bfhi(z1.x)); o1.y = pk(v[2][2] * rs * g2[2] * bflo(z1.y), v[2][3] * rs * g2[3] * bfhi(z1.y));
          o1.z = pk(v[3][0] * rs * g3[0] * bflo(z1.z), v[3][1] * rs * g3[1] * bfhi(z1.z)); o1.w = pk(v[3][2] * rs * g3[2] * bflo(z1.w), v[3][3] * rs * g3[3] * bfhi(z1.w));
          *(u32x4*)yp = o0; *(u32x4*)(yp + 8) = o1; }
#pragma unroll
        for (int mt = 0; mt < 4; ++mt) ucur[mt] = unxt[mt];
    }
#undef SC_DMA
    asm volatile("s_waitcnt vmcnt(0) lgkmcnt(0)\n\ts_barrier" ::: "memory");
}
}
constexpr int NWAVES = 8;
constexpr int BATCH = 2, T = 8192, D = 1024, M = BATCH * T;
constexpr int D_IN = 6152, NPROJ = 6144;
constexpr float EPS = 1e-6f;
constexpr float C2 = 0.125f * 1.4426950408889634f;

constexpr size_t MiB = 1u << 20;
constexpr size_t WS_CTL = 0, CTL_ZERO_BYTES = 1 * MiB;
constexpr size_t WS_WUP = 1 * MiB;
constexpr size_t WS_WOUT = 3 * MiB;
constexpr size_t WS_GB = 7 * MiB;
constexpr size_t WS_WIN = 8 * MiB;
constexpr size_t WS_UT = 8 * MiB;
constexpr size_t WS_GL = 24 * MiB;
constexpr size_t WS_XN = 32 * MiB;
constexpr size_t WS_YA = 32 * MiB, WS_YB = 48 * MiB;
constexpr size_t WS_QKVA = 64 * MiB;
constexpr size_t WS_ZA = 112 * MiB;
constexpr size_t WS_QKVB = 128 * MiB;
constexpr size_t WS_ZB = 176 * MiB;
constexpr size_t WS_GATE = 192 * MiB;
constexpr size_t WS_PBUF = 64 * MiB;
constexpr size_t WS_END = 256 * MiB;
constexpr int CW_BAR = 4096;
constexpr int CW_Q = 16384;

constexpr int RING_OFF = 0, RING_BYTES = 131072;
constexpr int LDSCTL_OFF = 162816, MISC_OFF = LDSCTL_OFF + 320;
constexpr int LDS_BYTES = 163840;

struct Frame {
    LAS unsigned char* lds; volatile LAS unsigned* MISC; gu32* ctl;
    int tid, lane, wave, vcu, G;
};

__device__ __forceinline__ float wave_sum(float v) {
#pragma unroll
    for (int o = 1; o < 64; o <<= 1) v += __shfl_xor(v, o);
    return v;
}
__device__ __forceinline__ float wave_max(float v) {
#pragma unroll
    for (int o = 1; o < 64; o <<= 1) v = fmaxf(v, __shfl_xor(v, o));
    return v;
}
__device__ __forceinline__ void p0_transpose_item(const float* W, int ldw, int src_n0, int k0, bf16* WT, int ldt, int dst_row0, int dst_k0, LAS float* scr, int lane) {
#pragma unroll 8
    for (int i = 0; i < 32; ++i) { const int kk = 2 * i + (lane >> 5); scr[kk * 33 + (lane & 31)] = W[(size_t)(k0 + kk) * ldw + src_n0 + (lane & 31)]; }
    LDS_WAIT(); asm volatile("" ::: "memory");
    const int c = lane & 7;
#pragma unroll
    for (int j = 0; j < 4; ++j) { const int n = (lane >> 3) + 8 * j; const LAS float* s = scr + (8 * c) * 33 + n;
        v4u o; o.x = pk2(s[0 * 33], s[1 * 33]); o.y = pk2(s[2 * 33], s[3 * 33]); o.z = pk2(s[4 * 33], s[5 * 33]); o.w = pk2(s[6 * 33], s[7 * 33]);
        *(GAS v4u*)(WT + (size_t)(dst_row0 + n) * ldt + dst_k0 + k0 + 8 * c) = o; }
    LDS_WAIT(); asm volatile("" ::: "memory");
}

struct Args { const float* in[14]; float* out; unsigned char* ws; };

__device__ __forceinline__ void p0_prologue(Frame& F, const Args& A) {
    const float* x = A.in[0]; const float* norm_w = A.in[1]; const float* w_in = A.in[2];
    const float* a_log = A.in[8]; const float* dt_bias = A.in[9];
    const float* w_upa = A.in[11]; const float* w_upb = A.in[12]; const float* w_out = A.in[13];
    bf16* WIN = (bf16*)(A.ws + WS_WIN); bf16* WUP = (bf16*)(A.ws + WS_WUP); bf16* WOUT = (bf16*)(A.ws + WS_WOUT); bf16* XN = (bf16*)(A.ws + WS_XN);
    float* GB = (float*)(A.ws + WS_GB);
    LAS float* wab = (LAS float*)(F.lds + RING_OFF + 98304);
    for (int i = F.tid; i < 1024 * 8; i += NWAVES * 64) { const int k = i >> 3, j = i & 7; wab[i] = w_in[(size_t)k * D_IN + 4096 + j] * norm_w[k]; }
    LAS float* scr = (LAS float*)(F.lds + RING_OFF + F.wave * 8704);
    const int gw = F.vcu * NWAVES + F.wave, NGW = F.G * NWAVES;
    constexpr int I_IN = 16 * 192, I_UP = 8 * 32, I_OUT = 16 * 32; constexpr int NITEMS = I_IN + 2 * I_UP + I_OUT;
    for (int it = gw; it < NITEMS; it += NGW) {
        int r = it;
        if (r < I_IN) { const int kb = r / 192, nb = r % 192; const int n0 = nb * 32;
            const int src = n0 + (n0 >= 4096 ? 8 : 0); const int tt = n0 & 255; const int pos = (n0 & ~255) + 128 * ((tt >> 5) & 1) + 32 * (tt >> 6);
            p0_transpose_item(w_in, D_IN, src, kb * 64, WIN, 1024, pos, 0, scr, F.lane); continue; } r -= I_IN;
        if (r < I_UP) { const int kb = r / 32, nb = r % 32; p0_transpose_item(w_upa, 1024, nb * 32, kb * 64, WUP, 512, nb * 32, 0, scr, F.lane); continue; } r -= I_UP;
        if (r < I_UP) { const int kb = r / 32, nb = r % 32; p0_transpose_item(w_upb, 1024, nb * 32, kb * 64, WUP, 512, 1024 + nb * 32, 0, scr, F.lane); continue; } r -= I_UP;
        { const int kb = r / 32, nb = r % 32; p0_transpose_item(w_out, 1024, nb * 32, kb * 64, WOUT, 2048, nb * 32, 0, scr, F.lane);
          p0_transpose_item(w_out, 1024, nb * 32, kb * 64, WOUT, 2048, nb * 32, 1024, scr, F.lane); }
    }
    __syncthreads();
    f32x4 nw[4];
#pragma unroll
    for (int j = 0; j < 4; ++j) nw[j] = *((const GAS f32x4*)norm_w + F.lane + 64 * j);
    for (int m = gw; m < M; m += NGW) {
        const GAS f32x4* xr = (const GAS f32x4*)(x + (size_t)m * D) + F.lane;
        f32x4 v[4]; float s2 = 0.f;
#pragma unroll
        for (int j = 0; j < 4; ++j) { v[j] = xr[64 * j]; s2 += (v[j].x * v[j].x + v[j].y * v[j].y) + (v[j].z * v[j].z + v[j].w * v[j].w); }
        const float rstd = 1.f / sqrtf(wave_sum(s2) * (1.f / D) + EPS);
        GAS unsigned long long* o8 = (GAS unsigned long long*)(XN + (size_t)m * D) + F.lane;
        float ab[8];
#pragma unroll
        for (int q = 0; q < 8; ++q) ab[q] = 0.f;
#pragma unroll
        for (int j = 0; j < 4; ++j) {
            const f32x4 hn = v[j] * rstd;
            const f32x4 h = hn * nw[j];
            o8[64 * j] = (unsigned long long)pk2(h.x, h.y) | ((unsigned long long)pk2(h.z, h.w) << 32);
#pragma unroll
            for (int e = 0; e < 4; ++e) { const int k = 4 * F.lane + 256 * j + e; const f32x4 w0 = *(const LAS f32x4*)(wab + k * 8), w1 = *(const LAS f32x4*)(wab + k * 8 + 4);
                const float hv = hn[e];
                ab[0] += hv * w0.x; ab[1] += hv * w0.y; ab[2] += hv * w0.z; ab[3] += hv * w0.w; ab[4] += hv * w1.x; ab[5] += hv * w1.y; ab[6] += hv * w1.z; ab[7] += hv * w1.w; }
        }
#pragma unroll
        for (int q = 0; q < 8; ++q) ab[q] = wave_sum(ab[q]);
        if (F.lane < 8) { float val = ab[0];
#pragma unroll
            for (int q = 1; q < 8; ++q) val = (F.lane == q) ? ab[q] : val;
            float res;
            if (F.lane < 4) { const float xx = val + dt_bias[F.lane]; const float sp = xx > 20.f ? xx : log1pf(expf(xx)); res = -expf(a_log[F.lane]) * sp; }
            else res = 1.f / (1.f + expf(-val));
            GB[(size_t)m * 8 + F.lane] = res; }
    }
}

__global__ void __launch_bounds__(NWAVES * 64, 2) hyb_fwd(Args args) {
    extern __shared__ __attribute__((aligned(16))) unsigned char lds[];
    Frame F;
    F.lds = (LAS unsigned char*)lds;
    F.MISC = (volatile LAS unsigned*)(F.lds + MISC_OFF);
    F.tid = threadIdx.x; F.lane = F.tid & 63; F.wave = __builtin_amdgcn_readfirstlane(F.tid >> 6);
    F.G = gridDim.x; { const int bx = blockIdx.x; F.vcu = (F.G % 8 == 0) ? (bx % 8) * (F.G / 8) + bx / 8 : bx; }
    unsigned char* ws = args.ws;
    F.ctl = (gu32*)(ws + WS_CTL);
    for (int u = F.tid; u < (LDS_BYTES - LDSCTL_OFF) / 4; u += NWAVES * 64) ((LAS unsigned*)(F.lds + LDSCTL_OFF))[u] = 0u;
    __syncthreads();
    XcdBarrier bar = xcd_barrier_post((unsigned*)(F.ctl + CW_BAR), F.MISC + 8);

    p0_prologue(F, args);
    xcd_barrier(bar);

    {
        pg8::Gemm g{(const pg8::bf16_t*)(ws + WS_XN), (const pg8::bf16_t*)(ws + WS_WIN), M, NPROJ, D}; pg8::StaticOrder S; S.init(M, NPROJ, F.G, (int)blockIdx.x);
        pg8::EpiProj E{(pg8::bf16_t*)(ws + WS_QKVA), (pg8::bf16_t*)(ws + WS_ZA), (pg8::bf16_t*)(ws + WS_QKVB), (pg8::bf16_t*)(ws + WS_ZB), (pg8::bf16_t*)(ws + WS_GATE), args.in[3], args.in[4], C2};
        pg8::gemm_phase<pg8::EpiProj, pg8::StaticOrder, true, true>(F.lds + RING_OFF, g, S, E);
    }
    xcd_barrier(bar);

    {
        const gdn::PrepT PP{(const gdn::bf16_t*)(ws + WS_QKVB), (const float*)(ws + WS_GB), args.in[7], (unsigned char*)args.out, (gdn::bf16_t*)(ws + WS_UT), (float*)(ws + WS_GL)};
        if (F.G == 256) for (int i = 0; i < 4; ++i) gdn::prep_unit(F.vcu >> 5, (F.vcu & 31) + 32 * i, PP, F.lds);
    }
    xcd_barrier(bar);

    {
        const int grp = F.vcu >> 5;
        if (F.G == 256 && (F.vcu & 31) == 0) {
            const gdn::ScanT SP{(const unsigned char*)args.out, (const gdn::bf16_t*)(ws + WS_UT), (const float*)(ws + WS_GL), (const gdn::bf16_t*)(ws + WS_ZB), (gdn::bf16_t*)(ws + WS_YB), args.in[10]};
            gdn::scan_bh(grp, SP, F.lds);
        }
        const float* lamp = args.in[5];
        const float l01 = wave_sum(lamp[F.lane] * lamp[64 + F.lane]), l23 = wave_sum(lamp[128 + F.lane] * lamp[192 + F.lane]);
        const float lam = expf(l01) - expf(l23) + 0.2f;
        const float mq = wave_max(fabsf(args.in[3][F.lane])), mk = wave_max(fabsf(args.in[4][F.lane]));
        const float negM = -(8.0f * 1.4426950408889634f * mq * mk);
        da::Tensors TT{(const da::bf16_t*)(ws + WS_QKVA), (const da::bf16_t*)(ws + WS_ZA), (da::bf16_t*)(ws + WS_YA), args.in[6], lam, negM};
        if (F.G == 256) for (;;) {
            if (F.tid == 0) F.MISC[16] = __hip_atomic_fetch_add(F.ctl + CW_Q + 64 * grp, 1u, RLX_AGENT);
            __syncthreads();
            const unsigned idx = F.MISC[16];
            if (idx >= 64u) break;
            da::attn_unit(grp >> 2, grp & 3, 63 - (int)idx, TT, (LAS char*)(F.lds + RING_OFF));
        }
    }
    xcd_barrier(bar);

    {
        pg8::Gemm g{(const pg8::bf16_t*)(ws + WS_YA), (const pg8::bf16_t*)(ws + WS_WUP), M, 2048, 512}; pg8::StaticOrder S; S.init(M, 2048, F.G, (int)blockIdx.x);
        S.aoff_bytes = WS_YB - WS_YA; S.aoff_pn = 4;
        pg8::EpiGate E{(pg8::bf16_t*)(ws + WS_PBUF), (const pg8::bf16_t*)(ws + WS_GATE), 2048};
        pg8::gemm_phase<pg8::EpiGate, pg8::StaticOrder, true, true>(F.lds + RING_OFF, g, S, E);
    }
    xcd_barrier(bar);

    {
        pg8::Gemm g{(const pg8::bf16_t*)(ws + WS_PBUF), (const pg8::bf16_t*)(ws + WS_WOUT), M, D, 2048}; pg8::StaticOrder S; S.init(M, D, F.G, (int)blockIdx.x);
        pg8::EpiOut E{args.in[0], args.out, D};
        pg8::gemm_phase<pg8::EpiOut, pg8::StaticOrder, true, true>(F.lds + RING_OFF, g, S, E);
    }
}

extern "C" void kernel_launch(void* const* d_in, const int* in_sizes, int n_in, void* d_out, int out_size, void* d_ws, size_t ws_size, hipStream_t stream) {
    static int grid = 0;
    if (grid == 0) {
        if (n_in != 14 || in_sizes[0] != M * D || out_size != M * D || ws_size < WS_END) { fprintf(stderr, "kernel_launch: unexpected shapes (n_in %d, in0 %d, out %d, ws %zu); nothing launched\n", n_in, n_in > 0 ? in_sizes[0] : -1, out_size, ws_size); grid = -1; return; }
        int dev = 0, cus = 0, per_cu = 0;
        if (hipGetDevice(&dev) != hipSuccess || hipDeviceGetAttribute(&cus, hipDeviceAttributeMultiprocessorCount, dev) != hipSuccess) { grid = -1; return; }
        if (hipFuncSetAttribute((const void*)hyb_fwd, hipFuncAttributeMaxDynamicSharedMemorySize, LDS_BYTES) != hipSuccess) { fprintf(stderr, "kernel_launch: hipFuncSetAttribute failed\n"); grid = -1; return; }
        if (hipOccupancyMaxActiveBlocksPerMultiprocessor(&per_cu, (const void*)hyb_fwd, NWAVES * 64, LDS_BYTES) != hipSuccess || per_cu < 1) { fprintf(stderr, "kernel_launch: occupancy query reports %d workgroups per CU\n", per_cu); per_cu = 1; }
        (void)hipGetLastError();
        grid = cus;
    }
    if (grid < 0) return;
    if (hipMemsetAsync((char*)d_ws + WS_CTL, 0, CTL_ZERO_BYTES, stream) != hipSuccess) return;
    Args a{};
    for (int i = 0; i < 14; ++i) a.in[i] = (const float*)d_in[i];
    a.out = (float*)d_out; a.ws = (unsigned char*)d_ws;
    hipLaunchKernelGGL(hyb_fwd, dim3(grid), dim3(NWAVES * 64), LDS_BYTES, stream, a);
}
```
